# Optimizing an MI355X kernel written in HIP

```python
import math
import jax, jax.numpy as jnp
from jax import lax
import numpy as np

D_MODEL = 2048
BATCH = 16
SEQ = 2048
DEPTH = 1

ATTN_WIDTH = D_MODEL // 2
SSM_WIDTH = D_MODEL - ATTN_WIDTH
N_HEADS = 16
HEAD_DIM = ATTN_WIDTH // N_HEADS
MOBA_BLOCK = 256
MOBA_TOPK = 3
Q_CHUNK = 8
SSM_GROUP = 16
SSM_GROUPS = SSM_WIDTH // SSM_GROUP
SSM_STATE = 64
D_FF = 4 * D_MODEL
PROJ_WIDTH = 3 * ATTN_WIDTH + SSM_WIDTH
EPS = 1e-6
DT_MIN = 1e-3
DT_MAX = 1e-1
NEG = -1e30

kernel_name = "hymba_moba_s5_hybrid_block"


def rms_norm_f32(x, g):
    xf = x.astype(jnp.float32)
    y = xf * lax.rsqrt(jnp.mean(xf * xf, axis=-1, keepdims=True) + EPS)
    return y * g.astype(jnp.float32)


def rms_norm(x, g):
    return rms_norm_f32(x, g).astype(x.dtype)


def alibi_slopes(n_heads):
    return jnp.exp2(-8.0 * (jnp.arange(n_heads, dtype=jnp.float32) + 1.0) / n_heads)


def moba_attention(q, k, v):
    B_, H, L, Dh = q.shape
    nb = -(-L // MOBA_BLOCK)
    pad = nb * MOBA_BLOCK - L
    k_blk = jnp.pad(k, ((0, 0), (0, 0), (0, pad), (0, 0))).reshape(B_, H, nb, MOBA_BLOCK, Dh)
    v_blk = jnp.pad(v, ((0, 0), (0, 0), (0, pad), (0, 0))).reshape(B_, H, nb, MOBA_BLOCK, Dh)
    k_mean = jnp.mean(k_blk, axis=3)
    top_k = min(MOBA_TOPK, nb - 1)
    slopes = alibi_slopes(H)[None, :, None, None]
    scale = Dh ** -0.5
    n_chunks = L // Q_CHUNK
    q_c = q.reshape(B_, H, n_chunks, Q_CHUNK, Dh).transpose(2, 0, 1, 3, 4)
    b_idx = jnp.arange(B_)[:, None, None, None]
    h_idx = jnp.arange(H)[None, :, None, None]
    blk_pos = jnp.arange(MOBA_BLOCK)
    blk_ids = jnp.arange(nb)

    def chunk_fn(args):
        qc, c = args
        t = c * Q_CHUNK + jnp.arange(Q_CHUNK)
        own = (c * Q_CHUNK) // MOBA_BLOCK
        k_own = lax.dynamic_index_in_dim(k_blk, own, axis=2, keepdims=False)
        v_own = lax.dynamic_index_in_dim(v_blk, own, axis=2, keepdims=False)
        s_own = own * MOBA_BLOCK + blk_pos
        dist_own = (t[:, None] - s_own[None, :]).astype(jnp.float32)
        logit_own = jnp.einsum('bhqd,bhkd->bhqk', qc, k_own) * scale - slopes * dist_own
        logit_own = jnp.where(s_own[None, :] <= t[:, None], logit_own, NEG)
        if top_k == 0:
            p = jax.nn.softmax(logit_own, axis=-1)
            return jnp.einsum('bhqk,bhkd->bhqd', p, v_own)
        gate = jnp.einsum('bhqd,bhnd->bhqn', qc, k_mean)
        gate = jnp.where(blk_ids < own, gate, NEG)
        _, sel = lax.top_k(gate, top_k)
        valid = jnp.arange(top_k) < jnp.minimum(own, top_k)
        k_sel = k_blk[b_idx, h_idx, sel]
        v_sel = v_blk[b_idx, h_idx, sel]
        s_pos = sel[..., None] * MOBA_BLOCK + blk_pos
        dist_past = (t[:, None, None] - s_pos).astype(jnp.float32)
        logit_past = jnp.einsum('bhqd,bhqjkd->bhqjk', qc, k_sel) * scale - slopes[..., None] * dist_past
        logit_past = jnp.where(valid[:, None], logit_past, NEG)
        n_past = top_k * MOBA_BLOCK
        logits = jnp.concatenate([logit_past.reshape(B_, H, Q_CHUNK, n_past), logit_own], axis=-1)
        p = jax.nn.softmax(logits, axis=-1)
        p_past = p[..., :n_past].reshape(B_, H, Q_CHUNK, top_k, MOBA_BLOCK)
        return (jnp.einsum('bhqjk,bhqjkd->bhqd', p_past, v_sel)
                + jnp.einsum('bhqk,bhkd->bhqd', p[..., n_past:], v_own))

    out = lax.map(chunk_fn, (q_c, jnp.arange(n_chunks)))
    return out.transpose(1, 2, 0, 3, 4).reshape(B_, H, L, Dh)


def s5_ssm(u, lambda_re, lambda_im, log_dt, b_re, b_im, c_re, c_im, d_skip):
    B_, L, _ = u.shape
    f32 = jnp.float32
    uf = u.astype(f32).reshape(B_, L, SSM_GROUPS, SSM_GROUP)
    dt = jnp.exp(log_dt.astype(f32))[:, None]
    lr = lambda_re.astype(f32)
    li = lambda_im.astype(f32)
    mag = jnp.exp(lr * dt)
    ab_re = mag * jnp.cos(li * dt)
    ab_im = mag * jnp.sin(li * dt)
    den = lr * lr + li * li
    nr = ab_re - 1.0
    f_re = (nr * lr + ab_im * li) / den
    f_im = (ab_im * lr - nr * li) / den
    br = b_re.astype(f32)
    bi = b_im.astype(f32)
    bb_re = f_re[..., None] * br - f_im[..., None] * bi
    bb_im = f_re[..., None] * bi + f_im[..., None] * br
    bu_re = jnp.einsum('blgh,gph->lbgp', uf, bb_re)
    bu_im = jnp.einsum('blgh,gph->lbgp', uf, bb_im)
    a_re = jnp.broadcast_to(ab_re, (L, 1, SSM_GROUPS, SSM_STATE))
    a_im = jnp.broadcast_to(ab_im, (L, 1, SSM_GROUPS, SSM_STATE))

    def combine(e_i, e_j):
        air, aii, bir, bii = e_i
        ajr, aji, bjr, bji = e_j
        return (ajr * air - aji * aii,
                ajr * aii + aji * air,
                ajr * bir - aji * bii + bjr,
                ajr * bii + aji * bir + bji)

    _, _, s_re, s_im = lax.associative_scan(combine, (a_re, a_im, bu_re, bu_im), axis=0)
    y = (jnp.einsum('lbgp,ghp->blgh', s_re, c_re.astype(f32))
         - jnp.einsum('lbgp,ghp->blgh', s_im, c_im.astype(f32)))
    y = y + d_skip.astype(f32).reshape(SSM_GROUPS, SSM_GROUP) * uf
    return y.reshape(B_, L, SSM_WIDTH)


def setup_inputs(seed: int = 0) -> dict:
    key = jax.random.key(seed)
    ks = jax.random.split(key, 24)
    f32 = jnp.float32
    nrm = lambda k, shape, s: jax.random.normal(k, shape, f32) * s
    gain = lambda k, shape: 1.0 + 0.02 * jax.random.normal(k, shape, f32)
    n_idx = jnp.arange(SSM_STATE, dtype=f32)
    return {
        "x": jax.random.normal(ks[0], (BATCH, SEQ, D_MODEL), f32),
        "norm1_gain": gain(ks[1], (DEPTH, D_MODEL)),
        "w_in": nrm(ks[2], (DEPTH, D_MODEL, PROJ_WIDTH), D_MODEL ** -0.5),
        "q_norm_gain": gain(ks[3], (DEPTH, HEAD_DIM)),
        "k_norm_gain": gain(ks[4], (DEPTH, HEAD_DIM)),
        "attn_out_gain": gain(ks[5], (DEPTH, ATTN_WIDTH)),
        "lambda_re": -0.5 + 0.01 * jax.random.normal(ks[6], (DEPTH, SSM_GROUPS, SSM_STATE), f32),
        "lambda_im": math.pi * n_idx + 0.01 * jax.random.normal(ks[7], (DEPTH, SSM_GROUPS, SSM_STATE), f32),
        "log_dt": jax.random.uniform(ks[8], (DEPTH, SSM_GROUPS), f32, math.log(DT_MIN), math.log(DT_MAX)),
        "b_re": nrm(ks[9], (DEPTH, SSM_GROUPS, SSM_STATE, SSM_GROUP), (2.0 * SSM_GROUP) ** -0.5),
        "b_im": nrm(ks[10], (DEPTH, SSM_GROUPS, SSM_STATE, SSM_GROUP), (2.0 * SSM_GROUP) ** -0.5),
        "c_re": nrm(ks[11], (DEPTH, SSM_GROUPS, SSM_GROUP, SSM_STATE), (2.0 * SSM_STATE) ** -0.5),
        "c_im": nrm(ks[12], (DEPTH, SSM_GROUPS, SSM_GROUP, SSM_STATE), (2.0 * SSM_STATE) ** -0.5),
        "d_skip": nrm(ks[13], (DEPTH, SSM_WIDTH), 1.0),
        "w_glu": nrm(ks[14], (DEPTH, SSM_WIDTH, SSM_WIDTH), SSM_WIDTH ** -0.5),
        "b_glu": nrm(ks[15], (DEPTH, SSM_WIDTH), 0.02),
        "ssm_out_gain": gain(ks[16], (DEPTH, SSM_WIDTH)),
        "w_out": nrm(ks[17], (DEPTH, D_MODEL, D_MODEL), D_MODEL ** -0.5),
        "norm2_gain": gain(ks[18], (DEPTH, D_MODEL)),
        "w_ff1": nrm(ks[19], (DEPTH, D_MODEL, D_FF), D_MODEL ** -0.5),
        "w_ff2": nrm(ks[20], (DEPTH, D_FF, D_MODEL), D_FF ** -0.5),
    }


def reference(x, norm1_gain, w_in, q_norm_gain, k_norm_gain, attn_out_gain,
              lambda_re, lambda_im, log_dt, b_re, b_im, c_re, c_im, d_skip,
              w_glu, b_glu, ssm_out_gain, w_out, norm2_gain, w_ff1, w_ff2):
    B_, L, _ = x.shape

    def to_heads(t):
        return t.reshape(B_, L, N_HEADS, HEAD_DIM).transpose(0, 2, 1, 3)

    for i in range(DEPTH):
        h = rms_norm(x, norm1_gain[i])
        proj = jnp.einsum('bld,de->ble', h, w_in[i])
        q, k, v, u = jnp.split(proj, [ATTN_WIDTH, 2 * ATTN_WIDTH, 3 * ATTN_WIDTH], axis=-1)
        qh = rms_norm_f32(to_heads(q), q_norm_gain[i])
        kh = rms_norm_f32(to_heads(k), k_norm_gain[i])
        vh = to_heads(v).astype(jnp.float32)
        attn = moba_attention(qh, kh, vh)
        attn = attn.transpose(0, 2, 1, 3).reshape(B_, L, ATTN_WIDTH)
        ssm = s5_ssm(u, lambda_re[i], lambda_im[i], log_dt[i], b_re[i], b_im[i],
                     c_re[i], c_im[i], d_skip[i])
        ssm = jax.nn.gelu(ssm)
        ssm = ssm * jax.nn.sigmoid(jnp.einsum('blc,ce->ble', ssm, w_glu[i].astype(jnp.float32))
                                   + b_glu[i].astype(jnp.float32))
        mixed = jnp.concatenate([rms_norm_f32(attn, attn_out_gain[i]),
                                 rms_norm_f32(ssm, ssm_out_gain[i])], axis=-1).astype(x.dtype)
        x = x + jnp.einsum('blc,cd->bld', mixed, w_out[i])
        h2 = rms_norm(x, norm2_gain[i])
        ff = jnp.square(jax.nn.relu(jnp.einsum('bld,df->blf', h2, w_ff1[i])))
        x = x + jnp.einsum('blf,fd->bld', ff, w_ff2[i])
    return x
```

```cpp
#include <hip/hip_runtime.h>
#include <cstdio>
#include <cstdint>

constexpr int BATCH = 16, SEQ = 2048, DM = 2048, MTOK = BATCH * SEQ;
constexpr int AW = 1024, SW = 1024, NPROJ = 4096, NH = 16, HD = 64, DFF = 8192, NBLK = 8, MOBA = 256;
constexpr int SG = 64, SC = 16, SP = 64;
constexpr int SCH = 16, NCH = SEQ / SCH;
constexpr int X3LD = SCH * SC + 2 * SP;
constexpr float EPS = 1e-6f;
constexpr float LOG2E = 1.4426950408889634f;
constexpr float QSCALE = 0.125f * LOG2E;
namespace pg8 {
#define PG8_LAS __attribute__((address_space(3)))
typedef unsigned short bf16_t;
typedef short bf16x8 __attribute__((ext_vector_type(8)));
typedef float f32x4 __attribute__((ext_vector_type(4)));
typedef unsigned u32x4 __attribute__((ext_vector_type(4)));
constexpr int BM = 256, BK = 64, HALF = 128, HTB = HALF * BK * 2  , STAGE_BYTES = 8 * HTB, NXCD = 8, WGM = 8;

__host__ __device__ __forceinline__ int lds_byte(int r, int c) { const int st = (r >> 4) * 2 + (c >> 5), rr = r & 15, cc = c & 31, ob = rr * 64 + cc * 2; return st * 1024 + (ob ^ (((ob >> 9) & 1) << 5)); }
__host__ __device__ __forceinline__ void stage_rc(int b, int& R, int& C) { const int st = b / 1024, sb = b % 1024, swz = sb ^ (((sb >> 9) & 1) << 5); R = (st >> 1) * 16 + swz / 64; C = (st & 1) * 32 + (swz % 64) / 2; }
__host__ __device__ __forceinline__ int perm32(int rho) { const int n = rho >> 4, i = rho & 15; return 8 * (i >> 2) + 4 * n + (i & 3); }

struct Unit { int pm, pn; };
struct Gemm { const bf16_t* A; const bf16_t* Bt; int M, N, K, lda, ldb; };

struct StaticOrder {
    int nM, nN, nwg, G, c;
    __host__ __device__ void init(int M, int N, int G_, int c_) { nM = M / BM; nN = N / BM; nwg = nM * nN; G = G_; c = c_; }
    __host__ __device__ bool next(int i, Unit& u) const {
        const long L = (long)i * G + c; if (L >= nwg) return false;
        int wgid = (int)L; { const int q = nwg / NXCD, r = nwg % NXCD, xcd = wgid % NXCD, off = wgid / NXCD; wgid = (xcd < r ? xcd * (q + 1) : r * (q + 1) + (xcd - r) * q) + off; }
        const int nig = WGM * nN, gid = wgid / nig, fm = gid * WGM, gsz = (nM - fm) < WGM ? (nM - fm) : WGM;
        u.pm = fm + ((wgid % nig) % gsz); u.pn = (wgid % nig) / gsz; return true;
    }
    __device__ __forceinline__ void a_ready(const Unit&) const {}
    __device__ __forceinline__ void done(const Unit&) const {}
};

__device__ __forceinline__ unsigned cvt_pk_bf16(float lo, float hi) { unsigned r; asm volatile("v_cvt_pk_bf16_f32 %0, %1, %2" : "=v"(r) : "v"(lo), "v"(hi)); return r; }
typedef float f32x2 __attribute__((ext_vector_type(2)));
template <class Epi, class Sched, bool ALIGN_EPI = false, bool SP2 = false>
__device__ __forceinline__ void gemm_phase(PG8_LAS unsigned char* lds, const Gemm g, const Sched& S, const Epi& E) {
    const int tid = threadIdx.x, wid = __builtin_amdgcn_readfirstlane(tid >> 6), lane = tid & 63, wr = wid >> 2, wc = wid & 3, fr = lane & 15, fq = lane >> 4;
    const int K = g.K, nt = K / BK;
    unsigned voffA[2], voffB[2];
#pragma unroll
    for (int i = 0; i < 2; ++i) { int R, C; stage_rc(tid * 16 + i * 8192, R, C); const int Rb = Epi::PERM ? ((R & ~31) + perm32(R & 31)) : R;
        voffA[i] = (unsigned)(R * g.lda + C) * 2u; voffB[i] = (unsigned)(Rb * g.ldb + C) * 2u; }
    const size_t kstep = (size_t)(BK * 2);
    const size_t hstepA = (size_t)HALF * g.lda * 2, hstepB = (size_t)HALF * g.ldb * 2;
    const size_t tstepA = 2 * hstepA, tstepB = 2 * hstepB;
    const unsigned ldsw = (unsigned)wid * 1024u;
    const int aoff = lds_byte(wr * 64 + fr, fq * 8), boff = lds_byte(wc * 32 + fr, fq * 8);
#define PG8_SA(b, h) (((b) * 2 + (h)) * HTB)
#define PG8_SB(b, h) ((4 + (b) * 2 + (h)) * HTB)
#define PG8_STAGE(bufoff, gbase, voff) do { _Pragma("unroll") for (int _i = 0; _i < 2; ++_i) \
        __builtin_amdgcn_global_load_lds((const unsigned*)((const char*)(gbase) + (voff)[_i]), (PG8_LAS unsigned*)(lds + (bufoff) + ldsw + _i * 8192), 16, 0, 0); } while (0)
#define PG8_LDA(dst, b, h) do { _Pragma("unroll") for (int m = 0; m < 4; ++m) _Pragma("unroll") for (int k = 0; k < 2; ++k) dst[m][k] = *(const PG8_LAS bf16x8*)(lds + PG8_SA(b, h) + aoff + m * 2048 + k * 1024); } while (0)
#define PG8_LDB(dst, b, h) do { _Pragma("unroll") for (int n = 0; n < 2; ++n) _Pragma("unroll") for (int k = 0; k < 2; ++k) dst[n][k] = *(const PG8_LAS bf16x8*)(lds + PG8_SB(b, h) + boff + n * 2048 + k * 1024); } while (0)
#define PG8_MMA(ai, bj, At, Bt) do { __builtin_amdgcn_s_setprio(1); _Pragma("unroll") for (int m = 0; m < 4; ++m) _Pragma("unroll") for (int n = 0; n < 2; ++n) _Pragma("unroll") for (int k = 0; k < 2; ++k) \
        acc[ai][bj][m][n] = __builtin_amdgcn_mfma_f32_16x16x32_bf16(Bt[n][k], At[m][k], acc[ai][bj][m][n], 0, 0, 0); __builtin_amdgcn_s_setprio(0); } while (0)
#define PG8_WAIT_V(n) asm volatile("s_waitcnt vmcnt(" #n ")" ::: "memory")
#define PG8_WAIT_L(n) asm volatile("s_waitcnt lgkmcnt(" #n ")" ::: "memory")
#define PG8_BAR __builtin_amdgcn_s_barrier()
#define PG8_SCHED __builtin_amdgcn_sched_barrier(0)
    Unit cur, nxt; int ui = 0;
    if (!S.next(0, cur)) return;
    f32x4 acc[2][2][4][2];
#pragma unroll
    for (int a = 0; a < 2; ++a)
#pragma unroll
        for (int b = 0; b < 2; ++b)
#pragma unroll
            for (int m = 0; m < 4; ++m)
#pragma unroll
                for (int n = 0; n < 2; ++n) acc[a][b][m][n] = (f32x4){0.f, 0.f, 0.f, 0.f};
    bf16x8 At[4][2], B0[2][2], B1[2][2];
    const char* cA = (const char*)g.A + (size_t)cur.pm * tstepA; const char* cB = (const char*)g.Bt + (size_t)cur.pn * tstepB;
    S.a_ready(cur);
    if constexpr (SP2) {
        PG8_STAGE(PG8_SB(0, 0), cB, voffB); PG8_STAGE(PG8_SB(0, 1), cB + hstepB, voffB); PG8_STAGE(PG8_SA(0, 0), cA, voffA); PG8_STAGE(PG8_SA(0, 1), cA + hstepA, voffA);
        if (wr == 1) PG8_BAR;
        PG8_WAIT_V(2); PG8_BAR;
        PG8_STAGE(PG8_SB(1, 0), cB + kstep, voffB); PG8_STAGE(PG8_SA(1, 0), cA + kstep, voffA); PG8_STAGE(PG8_SB(1, 1), cB + hstepB + kstep, voffB);
        PG8_WAIT_V(6); PG8_BAR;
    } else {
        PG8_STAGE(PG8_SB(0, 0), cB, voffB); PG8_STAGE(PG8_SA(0, 0), cA, voffA); PG8_STAGE(PG8_SB(0, 1), cB + hstepB, voffB); PG8_STAGE(PG8_SA(0, 1), cA + hstepA, voffA);
        if (wr == 1) PG8_BAR;
        PG8_WAIT_V(4); PG8_BAR;
        PG8_STAGE(PG8_SB(1, 0), cB + kstep, voffB); PG8_STAGE(PG8_SA(1, 0), cA + kstep, voffA); PG8_STAGE(PG8_SB(1, 1), cB + hstepB + kstep, voffB);
        PG8_WAIT_V(6); PG8_BAR;
    }
    for (;;) {
        const bool has_next = S.next(ui + 1, nxt);
        const char* nA = has_next ? (const char*)g.A + (size_t)nxt.pm * tstepA : cA; const char* nB = has_next ? (const char*)g.Bt + (size_t)nxt.pn * tstepB : cB;
        for (int t = 0; t < nt; t += 2) {
            const bool last = (t == nt - 2);
            const char* a1 = cA + (size_t)(t + 1) * kstep;
            const char* a2 = last ? nA : cA + (size_t)(t + 2) * kstep; const char* b2 = last ? nB : cB + (size_t)(t + 2) * kstep;
            const char* a3 = a2 + kstep; const char* b3 = b2 + kstep;
            if (last && has_next) S.a_ready(nxt);
            if constexpr (SP2) {
            PG8_LDB(B0, 0, 0); PG8_LDB(B1, 0, 1); PG8_SCHED; PG8_LDA(At, 0, 0); PG8_STAGE(PG8_SA(1, 1), a1 + hstepA, voffA);
            PG8_WAIT_V(8); PG8_WAIT_L(0); PG8_BAR; PG8_MMA(0, 0, At, B0); PG8_MMA(0, 1, At, B1); PG8_BAR; PG8_SCHED;
            PG8_LDA(At, 0, 1); PG8_STAGE(PG8_SB(0, 0), b2, voffB); PG8_STAGE(PG8_SB(0, 1), b2 + hstepB, voffB); PG8_STAGE(PG8_SA(0, 0), a2, voffA);
            PG8_WAIT_V(8); PG8_WAIT_L(0); PG8_BAR; PG8_MMA(1, 0, At, B0); PG8_MMA(1, 1, At, B1); PG8_BAR; PG8_SCHED;
            PG8_LDB(B0, 1, 0); PG8_LDB(B1, 1, 1); PG8_SCHED; PG8_LDA(At, 1, 0); PG8_STAGE(PG8_SA(0, 1), a2 + hstepA, voffA);
            PG8_WAIT_V(8); PG8_WAIT_L(0); PG8_BAR; PG8_MMA(0, 0, At, B0); PG8_MMA(0, 1, At, B1); PG8_BAR; PG8_SCHED;
            PG8_LDA(At, 1, 1); PG8_STAGE(PG8_SB(1, 0), b3, voffB); PG8_STAGE(PG8_SB(1, 1), b3 + hstepB, voffB); PG8_STAGE(PG8_SA(1, 0), a3, voffA);
            PG8_WAIT_V(8); PG8_WAIT_L(0); PG8_BAR; PG8_MMA(1, 0, At, B0); PG8_MMA(1, 1, At, B1); PG8_BAR; PG8_SCHED;
            } else {
            PG8_LDB(B0, 0, 0); PG8_SCHED; PG8_LDA(At, 0, 0); PG8_STAGE(PG8_SA(1, 1), a1 + hstepA, voffA);
            PG8_WAIT_L(8); PG8_BAR; PG8_WAIT_L(0); PG8_MMA(0, 0, At, B0); PG8_BAR; PG8_SCHED;
            PG8_LDB(B1, 0, 1); PG8_STAGE(PG8_SB(0, 0), b2, voffB);
            PG8_BAR; PG8_WAIT_L(0); PG8_MMA(0, 1, At, B1); PG8_BAR;
            PG8_LDA(At, 0, 1); PG8_STAGE(PG8_SA(0, 0), a2, voffA);
            PG8_BAR; PG8_WAIT_L(0); PG8_MMA(1, 0, At, B0); PG8_BAR; PG8_SCHED;
            PG8_STAGE(PG8_SB(0, 1), b2 + hstepB, voffB);
            PG8_WAIT_V(6); PG8_BAR; PG8_MMA(1, 1, At, B1); PG8_BAR;
            PG8_LDB(B0, 1, 0); PG8_SCHED; PG8_LDA(At, 1, 0); PG8_STAGE(PG8_SA(0, 1), a2 + hstepA, voffA);
            PG8_WAIT_L(8); PG8_BAR; PG8_WAIT_L(0); PG8_MMA(0, 0, At, B0); PG8_BAR; PG8_SCHED;
            PG8_LDB(B1, 1, 1); PG8_STAGE(PG8_SB(1, 0), b3, voffB);
            PG8_BAR; PG8_WAIT_L(0); PG8_MMA(0, 1, At, B1); PG8_BAR;
            PG8_LDA(At, 1, 1); PG8_STAGE(PG8_SA(1, 0), a3, voffA);
            PG8_BAR; PG8_WAIT_L(0); PG8_MMA(1, 0, At, B0); PG8_BAR; PG8_SCHED;
            PG8_STAGE(PG8_SB(1, 1), b3 + hstepB, voffB);
            PG8_WAIT_V(6); PG8_BAR; PG8_MMA(1, 1, At, B1); PG8_BAR;
            }
        }
        if constexpr (ALIGN_EPI) { if (wr == 0) PG8_BAR; }
        if constexpr (!Epi::AFTER_DRAIN) { E(acc, cur, wr, wc, fr, fq); S.done(cur); }
        if (!has_next) break;
#pragma unroll
        for (int a = 0; a < 2; ++a)
#pragma unroll
            for (int b = 0; b < 2; ++b)
#pragma unroll
                for (int m = 0; m < 4; ++m)
#pragma unroll
                    for (int n = 0; n < 2; ++n) acc[a][b][m][n] = (f32x4){0.f, 0.f, 0.f, 0.f};
        cur = nxt; cA = nA; cB = nB; ++ui;
        if constexpr (ALIGN_EPI) { if (wr == 1) PG8_BAR; }
    }
    PG8_WAIT_V(0);
    if constexpr (!ALIGN_EPI) { if (wr == 0) PG8_BAR; }
    PG8_BAR;
    if constexpr (Epi::AFTER_DRAIN) { E.fused(acc, cur, wr, wc, fr, fq, lds, wid, lane); S.done(cur); }
#undef PG8_SA
#undef PG8_SB
#undef PG8_STAGE
#undef PG8_LDA
#undef PG8_LDB
#undef PG8_MMA
#undef PG8_WAIT_V
#undef PG8_WAIT_L
#undef PG8_BAR
#undef PG8_SCHED
}
__device__ __forceinline__ u32x4 pack8(const f32x4 v0, const f32x4 v1) { u32x4 w; w.x = cvt_pk_bf16(v0[0], v0[1]); w.y = cvt_pk_bf16(v0[2], v0[3]); w.z = cvt_pk_bf16(v1[0], v1[1]); w.w = cvt_pk_bf16(v1[2], v1[3]); return w; }
__device__ __forceinline__ float bflo(unsigned w) { return __builtin_bit_cast(float, w << 16); }
__device__ __forceinline__ float bfhi(unsigned w) { return __builtin_bit_cast(float, w & 0xffff0000u); }
__device__ __forceinline__ float sq4(const f32x4 x) { return (x[0] * x[0] + x[1] * x[1]) + (x[2] * x[2] + x[3] * x[3]); }

struct EpiProj {
    static constexpr bool PERM = true, AFTER_DRAIN = false;
    bf16_t* Q; bf16_t* Kb; bf16_t* V; bf16_t* X3; float* kmean; const float* qg; const float* kg;
    __device__ __forceinline__ void operator()(const f32x4 (&acc)[2][2][4][2], const Unit& u, int wr, int wc, int fr, int fq) const {
        const int pn = u.pn;
        const int row0 = u.pm * BM + wr * 64 + fr;
        if (pn < 8) {
            const bool isq = pn < 4;
            const float* gp = isq ? qg : kg; const float gs = isq ? QSCALE : 1.0f;
            f32x4 gv[2][2];
#pragma unroll
            for (int bj = 0; bj < 2; ++bj)
#pragma unroll
                for (int n = 0; n < 2; ++n) gv[bj][n] = *(const f32x4*)(gp + 32 * bj + 8 * fq + 4 * n) * gs;
            const int head = (pn & 3) * 4 + wc;
            bf16_t* base = (isq ? Q : Kb) + head * 64 + 8 * fq;
            f32x4 cs[2][2];
#pragma unroll
            for (int bj = 0; bj < 2; ++bj)
#pragma unroll
                for (int n = 0; n < 2; ++n) cs[bj][n] = (f32x4){0.f, 0.f, 0.f, 0.f};
#pragma unroll
            for (int ai = 0; ai < 2; ++ai)
#pragma unroll
                for (int m = 0; m < 4; ++m) {
                    float ss = 0.f;
#pragma unroll
                    for (int bj = 0; bj < 2; ++bj)
#pragma unroll
                        for (int n = 0; n < 2; ++n) ss += sq4(acc[ai][bj][m][n]);
                    ss += __shfl_xor(ss, 16); ss += __shfl_xor(ss, 32);
                    const float rn = rsqrtf(ss * (1.0f / 64.0f) + EPS);
                    bf16_t* rowp = base + (size_t)(row0 + ai * HALF + m * 16) * AW;
#pragma unroll
                    for (int bj = 0; bj < 2; ++bj) {
                        const f32x4 v0 = acc[ai][bj][m][0] * rn * gv[bj][0], v1 = acc[ai][bj][m][1] * rn * gv[bj][1];
                        cs[bj][0] += v0; cs[bj][1] += v1;
                        *(u32x4*)(rowp + 32 * bj) = pack8(v0, v1);
                    }
                }
            if (!isq) {
                float* km = kmean + ((size_t)((u.pm >> 3) * NH + head) * NBLK + (u.pm & 7)) * HD + 8 * fq;
#pragma unroll
                for (int bj = 0; bj < 2; ++bj)
#pragma unroll
                    for (int n = 0; n < 2; ++n)
#pragma unroll
                        for (int e = 0; e < 4; ++e) {
                            float v = cs[bj][n][e];
                            v += __shfl_xor(v, 1); v += __shfl_xor(v, 2); v += __shfl_xor(v, 4); v += __shfl_xor(v, 8);
                            if (fr == 0) __hip_atomic_fetch_add(km + 32 * bj + 4 * n + e, v, __ATOMIC_RELAXED, __HIP_MEMORY_SCOPE_AGENT);
                        }
            }
        } else if (pn < 12) {
            bf16_t* base = V + (pn - 8) * 256 + wc * 32 + 8 * fq;
#pragma unroll
            for (int ai = 0; ai < 2; ++ai)
#pragma unroll
                for (int m = 0; m < 4; ++m) {
                    bf16_t* rowp = base + (size_t)(row0 + ai * HALF + m * 16) * AW;
#pragma unroll
                    for (int bj = 0; bj < 2; ++bj) *(u32x4*)(rowp + bj * HALF) = pack8(acc[ai][bj][m][0], acc[ai][bj][m][1]);
                }
        } else {
            const int b = u.pm >> 3;
#pragma unroll
            for (int bj = 0; bj < 2; ++bj) {
                const int ch = (pn - 12) * 256 + bj * HALF + wc * 32 + 8 * fq, g = ch >> 4, h0 = ch & 15;
#pragma unroll
                for (int ai = 0; ai < 2; ++ai)
#pragma unroll
                    for (int m = 0; m < 4; ++m) {
                        const int c16 = (u.pm & 7) * 16 + ai * 8 + wr * 4 + m;
                        bf16_t* p = X3 + ((size_t)(g * (BATCH * NCH) + b * NCH + c16)) * X3LD + fr * SC + h0;
                        *(u32x4*)p = pack8(acc[ai][bj][m][0], acc[ai][bj][m][1]);
                    }
            }
        }
    }
};

struct EpiGlu {
    static constexpr bool PERM = true, AFTER_DRAIN = false;
    const bf16_t* act; bf16_t* out; const float* bias;
    __device__ __forceinline__ void operator()(const f32x4 (&acc)[2][2][4][2], const Unit& u, int wr, int wc, int fr, int fq) const {
        const int row0 = u.pm * BM + wr * 64 + fr, col0 = u.pn * BM + wc * 32 + 8 * fq;
        f32x4 bv[2][2];
#pragma unroll
        for (int bj = 0; bj < 2; ++bj)
#pragma unroll
            for (int n = 0; n < 2; ++n) bv[bj][n] = *(const f32x4*)(bias + col0 + bj * HALF + 4 * n);
#pragma unroll
        for (int ai = 0; ai < 2; ++ai)
#pragma unroll
            for (int m = 0; m < 4; ++m) {
                const size_t off = (size_t)(row0 + ai * HALF + m * 16) * SW + col0;
#pragma unroll
                for (int bj = 0; bj < 2; ++bj) {
                    const u32x4 a = *(const u32x4*)(act + off + bj * HALF);
                    const f32x4 a0 = (f32x4){bflo(a.x), bfhi(a.x), bflo(a.y), bfhi(a.y)}, a1 = (f32x4){bflo(a.z), bfhi(a.z), bflo(a.w), bfhi(a.w)};
                    const f32x4 g0 = acc[ai][bj][m][0] + bv[bj][0], g1 = acc[ai][bj][m][1] + bv[bj][1];
                    f32x4 o0, o1;
#pragma unroll
                    for (int e = 0; e < 4; ++e) { o0[e] = a0[e] * __builtin_amdgcn_rcpf(1.0f + __builtin_amdgcn_exp2f(-LOG2E * g0[e])); o1[e] = a1[e] * __builtin_amdgcn_rcpf(1.0f + __builtin_amdgcn_exp2f(-LOG2E * g1[e])); }
                    *(u32x4*)(out + off + bj * HALF) = pack8(o0, o1);
                }
            }
    }
};

struct EpiWout {
    static constexpr bool PERM = true, AFTER_DRAIN = false;
    const float* x; float* x1; bf16_t* x1b; float* rowsq;
    __device__ __forceinline__ void operator()(const f32x4 (&acc)[2][2][4][2], const Unit& u, int wr, int wc, int fr, int fq) const {
        const int row0 = u.pm * BM + wr * 64 + fr, col0 = u.pn * BM + wc * 32 + 8 * fq;
#pragma unroll
        for (int ai = 0; ai < 2; ++ai)
#pragma unroll
            for (int m = 0; m < 4; ++m) {
                const int row = row0 + ai * HALF + m * 16; const size_t off = (size_t)row * DM + col0;
                float ss = 0.f;
#pragma unroll
                for (int bj = 0; bj < 2; ++bj) {
                    const f32x4 v0 = acc[ai][bj][m][0] + *(const f32x4*)(x + off + bj * HALF), v1 = acc[ai][bj][m][1] + *(const f32x4*)(x + off + bj * HALF + 4);
                    *(f32x4*)(x1 + off + bj * HALF) = v0; *(f32x4*)(x1 + off + bj * HALF + 4) = v1;
                    *(u32x4*)(x1b + off + bj * HALF) = pack8(v0, v1);
                    ss += sq4(v0) + sq4(v1);
                }
                ss += __shfl_xor(ss, 16); ss += __shfl_xor(ss, 32);
                if (fq == 0) __hip_atomic_fetch_add(rowsq + row, ss, __ATOMIC_RELAXED, __HIP_MEMORY_SCOPE_AGENT);
            }
    }
};

struct EpiFF1 {
    static constexpr bool PERM = true, AFTER_DRAIN = false;
    bf16_t* hid; const float* rowsq;
    __device__ __forceinline__ void operator()(const f32x4 (&acc)[2][2][4][2], const Unit& u, int wr, int wc, int fr, int fq) const {
        const int row0 = u.pm * BM + wr * 64 + fr, col0 = u.pn * BM + wc * 32 + 8 * fq;
#pragma unroll
        for (int ai = 0; ai < 2; ++ai)
#pragma unroll
            for (int m = 0; m < 4; ++m) {
                const int row = row0 + ai * HALF + m * 16;
                const float r2 = 1.0f / (rowsq[row] * (1.0f / (float)DM) + EPS);
                bf16_t* rowp = hid + (size_t)row * DFF + col0;
#pragma unroll
                for (int bj = 0; bj < 2; ++bj) {
                    f32x4 v0 = acc[ai][bj][m][0], v1 = acc[ai][bj][m][1];
#pragma unroll
                    for (int e = 0; e < 4; ++e) { const float a = fmaxf(v0[e], 0.f), b = fmaxf(v1[e], 0.f); v0[e] = a * a * r2; v1[e] = b * b * r2; }
                    *(u32x4*)(rowp + bj * HALF) = pack8(v0, v1);
                }
            }
    }
};

struct EpiFF2 {
    static constexpr bool PERM = false, AFTER_DRAIN = false;
    float* out;
    __device__ __forceinline__ void operator()(const f32x4 (&acc)[2][2][4][2], const Unit& u, int wr, int wc, int fr, int fq) const {
        const int row0 = u.pm * BM + wr * 64 + fr, col0 = u.pn * BM + wc * 32 + 4 * fq;
#pragma unroll
        for (int ai = 0; ai < 2; ++ai)
#pragma unroll
            for (int m = 0; m < 4; ++m) {
                float* rowp = out + (size_t)(row0 + ai * HALF + m * 16) * DM + col0;
#pragma unroll
                for (int bj = 0; bj < 2; ++bj)
#pragma unroll
                    for (int n = 0; n < 2; ++n) { float* p = rowp + bj * HALF + n * 16; *(f32x4*)p = *(const f32x4*)p + acc[ai][bj][m][n]; }
            }
    }
};
}
#define GAS __attribute__((address_space(1)))
#define LAS __attribute__((address_space(3)))
typedef unsigned short bf16;
typedef unsigned v4u __attribute__((ext_vector_type(4)));
typedef float f32x4 __attribute__((ext_vector_type(4)));
typedef short bf16x8 __attribute__((ext_vector_type(8)));
typedef GAS unsigned gu32;
typedef GAS unsigned long long gu64;
#define RLX_AGENT __ATOMIC_RELAXED, __HIP_MEMORY_SCOPE_AGENT
#define LDS_WAIT() asm volatile("s_waitcnt lgkmcnt(0)" ::: "memory")
#define VM_WAIT() asm volatile("s_waitcnt vmcnt(0)" ::: "memory")
__device__ __forceinline__ unsigned long long rt() { return __builtin_amdgcn_s_memrealtime(); }
__device__ __forceinline__ unsigned f2bf(float f) { unsigned u = __builtin_bit_cast(unsigned, f); return (u + 0x7fffu + ((u >> 16) & 1u)) >> 16; }
__device__ __forceinline__ unsigned pk2(float lo, float hi) { return f2bf(lo) | (f2bf(hi) << 16); }

#define XB_TMO      128
#define XB_XCNT(j)  (256  + 64 * (j))
#define XB_XSUB(j)  (1280 + 64 * (j))
#define XB_XGEN(j)  (2304 + 64 * (j))
#define XB_TOP      3328
#define XB_TOPGEN   3392
#define XCD_BAR_WORDS 3456
#define XB_SPIN_CAP (1u << 18)

__device__ __forceinline__ unsigned xb_ld(unsigned* p)              { return __hip_atomic_load(p, __ATOMIC_RELAXED, __HIP_MEMORY_SCOPE_AGENT); }
__device__ __forceinline__ unsigned xb_add(unsigned* p, unsigned v) { return __hip_atomic_fetch_add(p, v, __ATOMIC_RELAXED, __HIP_MEMORY_SCOPE_AGENT); }
__device__ __forceinline__ unsigned xb_xcc_id() { return (unsigned)__builtin_amdgcn_s_getreg((3 << 11) | 20) & 0xFu; }
#define XB_SPIN(cond, bar) do { unsigned _sp = 0; while (cond) { __builtin_amdgcn_s_sleep(1); \
    if ((++_sp & 255u) == 0u) { if (xb_ld(&(bar)[XB_TMO])) break; if (_sp > XB_SPIN_CAP) { atomicAdd(&(bar)[XB_TMO], 1u); break; } } } } while (0)

struct XcdBarrier {
    unsigned* bar; unsigned x;
    volatile LAS unsigned* st;
};

__device__ __forceinline__ XcdBarrier xcd_barrier_post(unsigned* bar, volatile LAS unsigned* st) {
    XcdBarrier b; b.bar = bar; b.x = xb_xcc_id(); b.st = st;
    if (threadIdx.x == 0) (void)xb_add(&bar[XB_XCNT(b.x)], 1u);
    return b;
}
__device__ __forceinline__ void xcd_barrier_complete(unsigned* bar, unsigned x, unsigned& nloc, unsigned& nx) {
    const unsigned G = gridDim.x * gridDim.y * gridDim.z;
    unsigned sum, cnt, mine, sp = 0u;
    for (;;) {
        sum = 0u; cnt = 0u; mine = 0u;
#pragma unroll
        for (unsigned j = 0; j < 16; ++j) { const unsigned c = xb_ld(&bar[XB_XCNT(j)]); sum += c; cnt += (c > 0u) ? 1u : 0u; mine = (j == x) ? c : mine; }
        if (sum == G) break;
        __builtin_amdgcn_s_sleep(1);
        if ((++sp & 255u) == 0u) { if (xb_ld(&bar[XB_TMO])) break; if (sp > XB_SPIN_CAP) { atomicAdd(&bar[XB_TMO], 1u); break; } }
    }
    nloc = mine > 0u ? mine : 1u; nx = cnt > 0u ? cnt : 1u;
}

__device__ __forceinline__ void xcd_barrier(const XcdBarrier& b) {
    asm volatile("s_waitcnt vmcnt(0)" ::: "memory");
    __syncthreads();
    if (threadIdx.x == 0) {
        unsigned* bar = b.bar;
        __builtin_amdgcn_s_waitcnt(0);
        unsigned nloc = b.st[0], nx = b.st[1];
        if (nloc == 0u) { xcd_barrier_complete(bar, b.x, nloc, nx); b.st[0] = nloc; b.st[1] = nx; }
        const unsigned old = xb_add(&bar[XB_XSUB(b.x)], 1u);
        const unsigned gen = old / nloc;
        if (old + 1u == (gen + 1u) * nloc) {
            __builtin_amdgcn_fence(__ATOMIC_RELEASE, "agent");
            asm volatile("s_waitcnt vmcnt(0)" ::: "memory");
            const unsigned og = xb_add(&bar[XB_TOP], 1u);
            const unsigned tg = og / nx;
            if (og + 1u == (tg + 1u) * nx) xb_add(&bar[XB_TOPGEN], 1u);
            else XB_SPIN(xb_ld(&bar[XB_TOPGEN]) == tg, bar);
            __builtin_amdgcn_fence(__ATOMIC_ACQUIRE, "agent");
            xb_add(&bar[XB_XGEN(b.x)], 1u);
            asm volatile("s_waitcnt vmcnt(0)" ::: "memory");
        } else {
            XB_SPIN(xb_ld(&bar[XB_XGEN(b.x)]) == gen, bar);
            __builtin_amdgcn_fence(__ATOMIC_ACQUIRE, "agent");
            asm volatile("s_waitcnt vmcnt(0)" ::: "memory");
        }
    }
    __syncthreads();
}

constexpr int NWAVES = 8;
constexpr size_t MiB = 1u << 20;
constexpr size_t WS_CTL = 0, CTL_ZERO_BYTES = 2 * MiB;
constexpr size_t WS_KMEAN = 1 * MiB;
constexpr size_t WS_ROWSQ = 1 * MiB + 512 * 1024;
constexpr size_t WS_WIN = 2 * MiB, WS_WGLU = 18 * MiB, WS_WOUT = 20 * MiB, WS_W1 = 28 * MiB, WS_W2 = 60 * MiB;
constexpr size_t WS_W3 = 92 * MiB, WS_F = 104 * MiB, WS_AT = 112 * MiB;
constexpr size_t WS_X1B = 128 * MiB;
constexpr size_t WS_HID = 256 * MiB;
constexpr size_t WS_XB = 256 * MiB;
constexpr size_t WS_Q = 384 * MiB, WS_K = 448 * MiB, WS_V = 512 * MiB;
constexpr size_t WS_X3 = 576 * MiB;
constexpr size_t WS_L = 672 * MiB;
constexpr size_t WS_ATT = 768 * MiB, WS_ACT = 832 * MiB, WS_SOUT = 896 * MiB, WS_END = 960 * MiB;
constexpr int CW_TMO = 0, CW_CODE = 1, CW_BAR = 4096;

constexpr int RING_OFF = 0, RING_BYTES = 131072;
constexpr int LDSCTL_OFF = RING_BYTES, MISC_OFF = LDSCTL_OFF + 320;
constexpr int LDS_BYTES = 147456;

struct Args { const float* in[21]; float* out; unsigned char* ws; };
struct Frame {
    LAS unsigned char* lds;
    volatile LAS unsigned* MISC;
    gu32* ctl;
    int tid, lane, wave, vcu, G;
};
__device__ __forceinline__ float wave_sum(float v) {
#pragma unroll
    for (int o = 1; o < 64; o <<= 1) v += __shfl_xor(v, o);
    return v;
}
__device__ __forceinline__ float bflo(unsigned w) { return __builtin_bit_cast(float, w << 16); }
__device__ __forceinline__ float bfhi(unsigned w) { return __builtin_bit_cast(float, w & 0xffff0000u); }
__device__ __forceinline__ float gelu_tanh(float y) {
    const float z = y * (1.0f + 0.044715f * y * y) * (-2.0f * 0.7978845608028654f * LOG2E);
    return y * __builtin_amdgcn_rcpf(1.0f + __builtin_amdgcn_exp2f(z));
}

template <int GAIN, bool PERMQ>
__device__ __forceinline__ void p0_transpose_item(const float* W, const float* gk, const float* gk2, int ksplit, int K, int N, bf16* WT, LAS float* scr, int item, int lane) {
    const int nblk = N / 32, kb = item / nblk, nb = item % nblk, k0 = 64 * kb, n0 = 32 * nb;
#pragma unroll 8
    for (int i = 0; i < 32; ++i) { const int kk = 2 * i + (lane >> 5), k = k0 + kk; float w = W[(size_t)k * N + n0 + (lane & 31)];
        if constexpr (GAIN == 1) w *= gk[k];
        if constexpr (GAIN == 2) { const float* gp = (k < ksplit) ? gk + k : gk2 + (k - ksplit); w *= *gp; }
        scr[kk * 33 + (lane & 31)] = w; }
    LDS_WAIT(); asm volatile("" ::: "memory");
    int d0 = n0;
    if (PERMQ && nb < 64) { const int w8 = nb & 7; d0 = (nb & ~7) * 32 + 32 * (4 * (w8 & 1) + (w8 >> 1)); }
    const int c = lane & 7;
#pragma unroll
    for (int j = 0; j < 4; ++j) { const int n = (lane >> 3) + 8 * j; const LAS float* s = scr + (8 * c) * 33 + n;
        v4u o; o.x = pk2(s[0 * 33], s[1 * 33]); o.y = pk2(s[2 * 33], s[3 * 33]); o.z = pk2(s[4 * 33], s[5 * 33]); o.w = pk2(s[6 * 33], s[7 * 33]);
        *(GAS v4u*)(WT + (size_t)(d0 + n) * K + k0 + 8 * c) = o; }
    LDS_WAIT(); asm volatile("" ::: "memory");
}
__device__ __forceinline__ void rms_row_to_bf16(const float* xrow, bf16* orow, int lane) {
    const GAS f32x4* xr = (const GAS f32x4*)xrow + lane;
    f32x4 v[8]; float s = 0.f;
#pragma unroll
    for (int j = 0; j < 8; ++j) { v[j] = xr[64 * j]; s += (v[j].x * v[j].x + v[j].y * v[j].y) + (v[j].z * v[j].z + v[j].w * v[j].w); }
    const float r = rsqrtf(wave_sum(s) * (1.0f / (float)DM) + EPS);
    GAS unsigned long long* o8 = (GAS unsigned long long*)orow + lane;
#pragma unroll
    for (int j = 0; j < 8; ++j) o8[64 * j] = (unsigned long long)pk2(v[j].x * r, v[j].y * r) | ((unsigned long long)pk2(v[j].z * r, v[j].w * r) << 32);
}
__device__ __forceinline__ void p0_prologue(Frame& F, const Args& A) {
    unsigned char* ws = A.ws;
    LAS float* scr = (LAS float*)(F.lds + RING_OFF + F.wave * 16384);
    const int gw = F.vcu * NWAVES + F.wave, NGW = F.G * NWAVES;
    constexpr int I_IN = (DM / 64) * (NPROJ / 32), I_GLU = (SW / 64) * (SW / 32), I_OUT = (DM / 64) * (DM / 32), I_1 = (DM / 64) * (DFF / 32), I_2 = (DFF / 64) * (DM / 32);
    constexpr int NITEMS = I_IN + I_GLU + I_OUT + I_1 + I_2;
    for (int it = gw; it < NITEMS; it += NGW) {
        int r = it;
        if (r < I_IN) { p0_transpose_item<1, true>(A.in[2], A.in[1], A.in[1], DM, DM, NPROJ, (bf16*)(ws + WS_WIN), scr, r, F.lane); continue; } r -= I_IN;
        if (r < I_GLU) { p0_transpose_item<0, false>(A.in[14], A.in[14], A.in[14], SW, SW, SW, (bf16*)(ws + WS_WGLU), scr, r, F.lane); continue; } r -= I_GLU;
        if (r < I_OUT) { p0_transpose_item<2, false>(A.in[17], A.in[5], A.in[16], AW, DM, DM, (bf16*)(ws + WS_WOUT), scr, r, F.lane); continue; } r -= I_OUT;
        if (r < I_1) { p0_transpose_item<1, false>(A.in[19], A.in[18], A.in[18], DM, DM, DFF, (bf16*)(ws + WS_W1), scr, r, F.lane); continue; } r -= I_1;
        p0_transpose_item<0, false>(A.in[20], A.in[20], A.in[20], DFF, DFF, DM, (bf16*)(ws + WS_W2), scr, r, F.lane);
    }
    for (int m = gw; m < MTOK; m += NGW) rms_row_to_bf16(A.in[0] + (size_t)m * DM, (bf16*)(ws + WS_XB) + (size_t)m * DM, F.lane);
}

__device__ __forceinline__ void attn_naive(Frame& F, const bf16* Q, const bf16* K, const bf16* V, const float* kmean, bf16* O) {
    const int gw = F.vcu * NWAVES + F.wave, NGW = F.G * NWAVES;
    for (int it = gw; it < BATCH * NH * (SEQ / 64); it += NGW) {
        const int bh = it >> 5, tb = it & 31, b = bh >> 4, h = bh & 15, own = tb >> 2;
        const int t = tb * 64 + F.lane;
        const size_t row = (size_t)b * SEQ + t;
        float q[64];
        { const GAS v4u* qp = (const GAS v4u*)(Q + row * AW + h * HD);
#pragma unroll
          for (int i = 0; i < 8; ++i) { const v4u w = qp[i]; q[8 * i] = bflo(w.x); q[8 * i + 1] = bfhi(w.x); q[8 * i + 2] = bflo(w.y); q[8 * i + 3] = bfhi(w.y); q[8 * i + 4] = bflo(w.z); q[8 * i + 5] = bfhi(w.z); q[8 * i + 6] = bflo(w.w); q[8 * i + 7] = bfhi(w.w); } }
        unsigned sel = 0u;
        if (own > 0) {
            float gate[7];
#pragma unroll
            for (int j = 0; j < 7; ++j) { float s = 0.f; if (j < own) { const GAS float* km = (const GAS float*)kmean + ((size_t)bh * NBLK + j) * HD;
#pragma unroll
                for (int d = 0; d < 64; ++d) s += q[d] * km[d]; } gate[j] = s; }
#pragma unroll
            for (int j = 0; j < 7; ++j) if (j < own) { int cnt = 0;
#pragma unroll
                for (int i = 0; i < 7; ++i) if (i != j && i < own) cnt += (gate[i] > gate[j] || (gate[i] == gate[j] && i < j)) ? 1 : 0;
                if (cnt < 3) sel |= 1u << j; }
        }
        float mx = -1e30f, l = 0.f, o[64];
#pragma unroll
        for (int d = 0; d < 64; ++d) o[d] = 0.f;
        const float sl2 = __builtin_amdgcn_exp2f(-0.5f * (float)(h + 1)) * LOG2E;
        for (int jb = 0; jb <= own; ++jb) {
            const bool mine = (jb == own) || (((sel >> jb) & 1u) != 0u);
            if (!__any(mine ? 1 : 0)) continue;
            const int kend = (jb == own) ? ((tb & 3) * 64 + 64) : MOBA;
            for (int kk = 0; kk < kend; ++kk) {
                const int s = jb * MOBA + kk;
                const size_t koff = ((size_t)b * SEQ + s) * AW + h * HD;
                float dot = 0.f;
                { const GAS v4u* kp = (const GAS v4u*)(K + koff);
#pragma unroll
                  for (int i = 0; i < 8; ++i) { const v4u w = kp[i]; dot += (q[8 * i] * bflo(w.x) + q[8 * i + 1] * bfhi(w.x)) + (q[8 * i + 2] * bflo(w.y) + q[8 * i + 3] * bfhi(w.y)) + (q[8 * i + 4] * bflo(w.z) + q[8 * i + 5] * bfhi(w.z)) + (q[8 * i + 6] * bflo(w.w) + q[8 * i + 7] * bfhi(w.w)); } }
                const float x = dot + sl2 * (float)(s - own * MOBA);
                const bool valid = mine && (s <= t);
                if (valid && x > mx) { const float al = __builtin_amdgcn_exp2f(mx - x); l *= al;
#pragma unroll
                    for (int d = 0; d < 64; ++d) o[d] *= al;
                    mx = x; }
                const float p = valid ? __builtin_amdgcn_exp2f(x - mx) : 0.f;
                l += p;
                { const GAS v4u* vp = (const GAS v4u*)(V + koff);
#pragma unroll
                  for (int i = 0; i < 8; ++i) { const v4u w = vp[i]; o[8 * i] += p * bflo(w.x); o[8 * i + 1] += p * bfhi(w.x); o[8 * i + 2] += p * bflo(w.y); o[8 * i + 3] += p * bfhi(w.y); o[8 * i + 4] += p * bflo(w.z); o[8 * i + 5] += p * bfhi(w.z); o[8 * i + 6] += p * bflo(w.w); o[8 * i + 7] += p * bfhi(w.w); } }
            }
        }
        const float il = 1.0f / l;
        GAS v4u* op = (GAS v4u*)(O + row * AW + h * HD);
#pragma unroll
        for (int i = 0; i < 8; ++i) { v4u w; w.x = pk2(o[8 * i] * il, o[8 * i + 1] * il); w.y = pk2(o[8 * i + 2] * il, o[8 * i + 3] * il); w.z = pk2(o[8 * i + 4] * il, o[8 * i + 5] * il); w.w = pk2(o[8 * i + 6] * il, o[8 * i + 7] * il); op[i] = w; }
    }
}

__device__ __forceinline__ void ssm_naive(Frame& F, const Args& A, const bf16* X3, bf16* ACT) {
    LAS float* ub = (LAS float*)(F.lds + RING_OFF + F.wave * 2048);
    const int gw = F.vcu * NWAVES + F.wave, NGW = F.G * NWAVES, lane = F.lane;
    for (int it = gw; it < SG * BATCH; it += NGW) {
        const int g = it >> 4, b = it & 15, p = lane;
        const float dt = expf(A.in[8][g]);
        const float lr = A.in[6][g * SP + p], li = A.in[7][g * SP + p];
        const float mag = expf(lr * dt), a_re = mag * cosf(li * dt), a_im = mag * sinf(li * dt);
        const float den = lr * lr + li * li, nr = a_re - 1.0f;
        const float f_re = (nr * lr + a_im * li) / den, f_im = (a_im * lr - nr * li) / den;
        float bbr[16], bbi[16], cr[16], ci[16];
#pragma unroll
        for (int h = 0; h < 16; ++h) { const float br = A.in[9][(size_t)(g * SP + p) * SC + h], bi = A.in[10][(size_t)(g * SP + p) * SC + h];
            bbr[h] = f_re * br - f_im * bi; bbi[h] = f_re * bi + f_im * br;
            cr[h] = A.in[11][(size_t)(g * SC + h) * SP + p]; ci[h] = A.in[12][(size_t)(g * SC + h) * SP + p]; }
        const int hl = lane >> 2;
        const float dl = A.in[13][g * SC + hl];
        float s_re = 0.f, s_im = 0.f;
        for (int c = 0; c < NCH; ++c) {
            const GAS unsigned long long* src = (const GAS unsigned long long*)(X3 + ((size_t)(g * (BATCH * NCH) + b * NCH + c)) * X3LD);
            const unsigned long long w = src[lane];
            ub[4 * lane] = bflo((unsigned)w); ub[4 * lane + 1] = bfhi((unsigned)w); ub[4 * lane + 2] = bflo((unsigned)(w >> 32)); ub[4 * lane + 3] = bfhi((unsigned)(w >> 32));
            LDS_WAIT(); asm volatile("" ::: "memory");
            for (int j = 0; j < SCH; ++j) {
                float bur = 0.f, bui = 0.f;
#pragma unroll
                for (int h = 0; h < 16; ++h) { const float uh = ub[j * SC + h]; bur += bbr[h] * uh; bui += bbi[h] * uh; }
                const float nre = a_re * s_re - a_im * s_im + bur, nim = a_re * s_im + a_im * s_re + bui; s_re = nre; s_im = nim;
                float r8[8], r4[4], r2[2], r1;
                const bool b5 = (lane & 32) != 0, b4 = (lane & 16) != 0, b3 = (lane & 8) != 0, b2 = (lane & 4) != 0;
#pragma unroll
                for (int k = 0; k < 8; ++k) { const float lo = cr[k] * s_re - ci[k] * s_im, hi = cr[k + 8] * s_re - ci[k + 8] * s_im; const float send = b5 ? lo : hi, keep = b5 ? hi : lo; r8[k] = keep + __shfl_xor(send, 32); }
#pragma unroll
                for (int k = 0; k < 4; ++k) { const float send = b4 ? r8[k] : r8[k + 4], keep = b4 ? r8[k + 4] : r8[k]; r4[k] = keep + __shfl_xor(send, 16); }
#pragma unroll
                for (int k = 0; k < 2; ++k) { const float send = b3 ? r4[k] : r4[k + 2], keep = b3 ? r4[k + 2] : r4[k]; r2[k] = keep + __shfl_xor(send, 8); }
                { const float send = b2 ? r2[0] : r2[1], keep = b2 ? r2[1] : r2[0]; r1 = keep + __shfl_xor(send, 4); }
                r1 += __shfl_xor(r1, 2); r1 += __shfl_xor(r1, 1);
                const float y = r1 + dl * ub[j * SC + hl];
                if ((lane & 3) == 0) ACT[((size_t)b * SEQ + c * SCH + j) * SW + g * SC + hl] = (bf16)f2bf(gelu_tanh(y));
            }
            LDS_WAIT(); asm volatile("" ::: "memory");
        }
    }
}

__device__ __forceinline__ void mix_rows(Frame& F, const bf16* ATT, const bf16* SOUT, bf16* MIX) {
    const int gw = F.vcu * NWAVES + F.wave, NGW = F.G * NWAVES, lane = F.lane;
    for (int m = gw; m < MTOK; m += NGW) {
        const GAS v4u* ap = (const GAS v4u*)(ATT + (size_t)m * AW) + lane; const GAS v4u* sp = (const GAS v4u*)(SOUT + (size_t)m * SW) + lane;
        v4u w[4]; w[0] = ap[0]; w[1] = ap[64]; w[2] = sp[0]; w[3] = sp[64];
        float f[4][8]; float ssa = 0.f, sss = 0.f;
#pragma unroll
        for (int i = 0; i < 4; ++i) { f[i][0] = bflo(w[i].x); f[i][1] = bfhi(w[i].x); f[i][2] = bflo(w[i].y); f[i][3] = bfhi(w[i].y); f[i][4] = bflo(w[i].z); f[i][5] = bfhi(w[i].z); f[i][6] = bflo(w[i].w); f[i][7] = bfhi(w[i].w);
            float s = 0.f;
#pragma unroll
            for (int e = 0; e < 8; ++e) s += f[i][e] * f[i][e];
            if (i < 2) ssa += s; else sss += s; }
        const float ra = rsqrtf(wave_sum(ssa) * (1.0f / (float)AW) + EPS), rs = rsqrtf(wave_sum(sss) * (1.0f / (float)SW) + EPS);
        GAS v4u* op = (GAS v4u*)(MIX + (size_t)m * DM) + lane;
#pragma unroll
        for (int i = 0; i < 4; ++i) { const float r = i < 2 ? ra : rs; v4u o; o.x = pk2(f[i][0] * r, f[i][1] * r); o.y = pk2(f[i][2] * r, f[i][3] * r); o.z = pk2(f[i][4] * r, f[i][5] * r); o.w = pk2(f[i][6] * r, f[i][7] * r); op[64 * i] = o; }
    }
}

__global__ void __launch_bounds__(NWAVES * 64, 2) hymba_fwd(Args args) {
    extern __shared__ __attribute__((aligned(16))) unsigned char lds[];
    Frame F;
    F.lds = (LAS unsigned char*)lds;
    F.MISC = (volatile LAS unsigned*)(F.lds + MISC_OFF);
    F.tid = threadIdx.x; F.lane = F.tid & 63; F.wave = __builtin_amdgcn_readfirstlane(F.tid >> 6);
    F.G = gridDim.x; { const int bx = blockIdx.x; F.vcu = (F.G % 8 == 0) ? (bx % 8) * (F.G / 8) + bx / 8 : bx; }
    unsigned char* ws = args.ws;
    F.ctl = (gu32*)(ws + WS_CTL);
    for (int u = F.tid; u < (LDS_BYTES - LDSCTL_OFF) / 4; u += NWAVES * 64) ((LAS unsigned*)(F.lds + LDSCTL_OFF))[u] = 0u;
    __syncthreads();
    XcdBarrier bar = xcd_barrier_post((unsigned*)(F.ctl + CW_BAR), F.MISC + 8);
#define GRID_BAR() xcd_barrier(bar)
    bf16* const XB = (bf16*)(ws + WS_XB); bf16* const QB = (bf16*)(ws + WS_Q); bf16* const KB = (bf16*)(ws + WS_K); bf16* const VB = (bf16*)(ws + WS_V);
    bf16* const X3 = (bf16*)(ws + WS_X3); bf16* const ATT = (bf16*)(ws + WS_ATT); bf16* const ACT = (bf16*)(ws + WS_ACT); bf16* const SOUT = (bf16*)(ws + WS_SOUT);
    bf16* const X1B = (bf16*)(ws + WS_X1B); bf16* const HID = (bf16*)(ws + WS_HID);
    float* const KMEAN = (float*)(ws + WS_KMEAN); float* const ROWSQ = (float*)(ws + WS_ROWSQ);

    p0_prologue(F, args);
    GRID_BAR();
    {   pg8::Gemm g{XB, (const bf16*)(ws + WS_WIN), MTOK, NPROJ, DM, DM, DM}; pg8::StaticOrder S; S.init(MTOK, NPROJ, F.G, (int)blockIdx.x);
        pg8::EpiProj E{QB, KB, VB, X3, KMEAN, args.in[3], args.in[4]};
        pg8::gemm_phase<pg8::EpiProj, pg8::StaticOrder, true, true>(F.lds + RING_OFF, g, S, E); }
    GRID_BAR();
    attn_naive(F, QB, KB, VB, KMEAN, ATT);
    ssm_naive(F, args, X3, ACT);
    GRID_BAR();
    {   pg8::Gemm g{ACT, (const bf16*)(ws + WS_WGLU), MTOK, SW, SW, SW, SW}; pg8::StaticOrder S; S.init(MTOK, SW, F.G, (int)blockIdx.x);
        pg8::EpiGlu E{ACT, SOUT, args.in[15]};
        pg8::gemm_phase<pg8::EpiGlu, pg8::StaticOrder, true, true>(F.lds + RING_OFF, g, S, E); }
    GRID_BAR();
    mix_rows(F, ATT, SOUT, XB);
    GRID_BAR();
    {   pg8::Gemm g{XB, (const bf16*)(ws + WS_WOUT), MTOK, DM, DM, DM, DM}; pg8::StaticOrder S; S.init(MTOK, DM, F.G, (int)blockIdx.x);
        pg8::EpiWout E{args.in[0], args.out, X1B, ROWSQ};
        pg8::gemm_phase<pg8::EpiWout, pg8::StaticOrder, true, true>(F.lds + RING_OFF, g, S, E); }
    GRID_BAR();
    {   pg8::Gemm g{X1B, (const bf16*)(ws + WS_W1), MTOK, DFF, DM, DM, DM}; pg8::StaticOrder S; S.init(MTOK, DFF, F.G, (int)blockIdx.x);
        pg8::EpiFF1 E{HID, ROWSQ};
        pg8::gemm_phase<pg8::EpiFF1, pg8::StaticOrder, true, true>(F.lds + RING_OFF, g, S, E); }
    GRID_BAR();
    {   pg8::Gemm g{HID, (const bf16*)(ws + WS_W2), MTOK, DM, DFF, DFF, DFF}; pg8::StaticOrder S; S.init(MTOK, DM, F.G, (int)blockIdx.x);
        pg8::EpiFF2 E{args.out};
        pg8::gemm_phase<pg8::EpiFF2, pg8::StaticOrder, true, true>(F.lds + RING_OFF, g, S, E); }
#undef GRID_BAR
}

extern "C" void kernel_launch(void* const* d_in, const int* in_sizes, int n_in, void* d_out, int out_size, void* d_ws, size_t ws_size, hipStream_t stream) {
    static int grid = 0;
    if (grid == 0) {
        if (n_in != 21 || in_sizes[0] != MTOK * DM || out_size != MTOK * DM || ws_size < WS_END) { fprintf(stderr, "kernel_launch: unexpected shapes (n_in %d, in0 %d, out %d, ws %zu); nothing launched\n", n_in, n_in > 0 ? in_sizes[0] : -1, out_size, ws_size); grid = -1; return; }
        int dev = 0, cus = 0, per_cu = 0;
        if (hipGetDevice(&dev) != hipSuccess || hipDeviceGetAttribute(&cus, hipDeviceAttributeMultiprocessorCount, dev) != hipSuccess) { grid = -1; return; }
        if (hipFuncSetAttribute((const void*)hymba_fwd, hipFuncAttributeMaxDynamicSharedMemorySize, LDS_BYTES) != hipSuccess) { fprintf(stderr, "kernel_launch: hipFuncSetAttribute failed\n"); grid = -1; return; }
        if (hipOccupancyMaxActiveBlocksPerMultiprocessor(&per_cu, (const void*)hymba_fwd, NWAVES * 64, LDS_BYTES) != hipSuccess || per_cu < 1) { fprintf(stderr, "kernel_launch: occupancy query reports %d workgroups per CU\n", per_cu); (void)hipGetLastError(); grid = -1; return; }
        grid = cus;
    }
    if (grid < 0) return;
    if (hipMemsetAsync((char*)d_ws + WS_CTL, 0, CTL_ZERO_BYTES, stream) != hipSuccess) return;
    Args a{};
    for (int i = 0; i < 21; ++i) a.in[i] = (const float*)d_in[i];
    a.out = (float*)d_out; a.ws = (unsigned char*)d_ws;
    hipLaunchKernelGGL(hymba_fwd, dim3(grid), dim3(NWAVES * 64), LDS_BYTES, stream, a);
}
```

```cpp
#include <hip/hip_runtime.h>
#include <cstdio>
#include <cstdint>

constexpr int BATCH = 16, SEQ = 2048, DM = 2048, MTOK = BATCH * SEQ;
constexpr int AW = 1024, SW = 1024, NPROJ = 4096, NH = 16, HD = 64, DFF = 8192, NBLK = 8, MOBA = 256;
constexpr int SG = 64, SC = 16, SP = 64;
constexpr int SCH = 16, NCH = SEQ / SCH;
constexpr int X3LD = SCH * SC + 2 * SP;
constexpr int LDM = DM + 64, LDF = DFF + 64, LDS1 = SW + 64;
constexpr float EPS = 1e-6f;
constexpr float LOG2E = 1.4426950408889634f;
constexpr float QSCALE = 0.125f * LOG2E;

template <int MASK> __device__ __forceinline__ float shx(float v) { static_assert(MASK >= 1 && MASK <= 16, "shx"); return __builtin_bit_cast(float, __builtin_amdgcn_ds_swizzle(__builtin_bit_cast(int, v), (MASK << 10) | 0x1f)); }
__device__ __forceinline__ float xsum32(float v) { auto rr = __builtin_amdgcn_permlane32_swap(__float_as_uint(v), __float_as_uint(v), false, false); unsigned a = rr[0], b = rr[1]; asm volatile("" : "+v"(a), "+v"(b)); return __uint_as_float(a) + __uint_as_float(b); }
namespace pg8 {
#define PG8_LAS __attribute__((address_space(3)))
typedef unsigned short bf16_t;
typedef short bf16x8 __attribute__((ext_vector_type(8)));
typedef float f32x4 __attribute__((ext_vector_type(4)));
typedef unsigned u32x4 __attribute__((ext_vector_type(4)));
constexpr int BM = 256, BK = 64, HALF = 128, HTB = HALF * BK * 2  , STAGE_BYTES = 8 * HTB, NXCD = 8, WGM = 8;

__host__ __device__ __forceinline__ int lds_byte(int r, int c) { const int st = (r >> 4) * 2 + (c >> 5), rr = r & 15, cc = c & 31, ob = rr * 64 + cc * 2; return st * 1024 + (ob ^ (((ob >> 9) & 1) << 5)); }
__host__ __device__ __forceinline__ void stage_rc(int b, int& R, int& C) { const int st = b / 1024, sb = b % 1024, swz = sb ^ (((sb >> 9) & 1) << 5); R = (st >> 1) * 16 + swz / 64; C = (st & 1) * 32 + (swz % 64) / 2; }
__host__ __device__ __forceinline__ int perm32(int rho) { const int n = rho >> 4, i = rho & 15; return 8 * (i >> 2) + 4 * n + (i & 3); }

__host__ __device__ __forceinline__ int img_in(int r, int c) { return (r >> 7) * (HTB / 2) + lds_byte(r & 127, c) / 2; }
__host__ __device__ __forceinline__ int inv_perm32(int w) { return 16 * ((w >> 2) & 1) + 4 * (w >> 3) + (w & 3); }
struct Unit { int pm, pn; };
struct Gemm { const bf16_t* A; const bf16_t* Bt; int M, N, K, lda, ldb; bool blkA = false, blkB = false; };

struct StaticOrder {
    int nM, nN, nwg, G, c, wgm;
    __host__ __device__ void init(int M, int N, int G_, int c_, int wgm_ = WGM) { nM = M / BM; nN = N / BM; nwg = nM * nN; G = G_; c = c_; wgm = wgm_; }
    __host__ __device__ bool next(int i, Unit& u) const {
        const long L = (long)i * G + c; if (L >= nwg) return false;
        int wgid = (int)L; { const int q = nwg / NXCD, r = nwg % NXCD, xcd = wgid % NXCD, off = wgid / NXCD; wgid = (xcd < r ? xcd * (q + 1) : r * (q + 1) + (xcd - r) * q) + off; }
        const int nig = wgm * nN, gid = wgid / nig, fm = gid * wgm, gsz = (nM - fm) < wgm ? (nM - fm) : wgm;
        u.pm = fm + ((wgid % nig) % gsz); u.pn = (wgid % nig) / gsz; return true;
    }
    __device__ __forceinline__ void a_ready(const Unit&) const {}
    __device__ __forceinline__ void done(const Unit&) const {}
};

__device__ __forceinline__ unsigned cvt_pk_bf16(float lo, float hi) { unsigned r; asm volatile("v_cvt_pk_bf16_f32 %0, %1, %2" : "=v"(r) : "v"(lo), "v"(hi)); return r; }
typedef float f32x2 __attribute__((ext_vector_type(2)));
template <class Epi, class Sched, bool ALIGN_EPI = false, bool SP2 = false>
__device__ __forceinline__ void gemm_phase(PG8_LAS unsigned char* lds, const Gemm g, const Sched& S, const Epi& E) {
    int tid_ = threadIdx.x; asm volatile("" : "+v"(tid_));
    const int tid = tid_, wid = __builtin_amdgcn_readfirstlane(tid >> 6), lane = tid & 63, wr = wid >> 2, wc = wid & 3, fr = lane & 15, fq = lane >> 4;
    const int K = g.K, nt = K / BK;
    unsigned voffA[2], voffB[2];
#pragma unroll
    for (int i = 0; i < 2; ++i) { int R, C; stage_rc(tid * 16 + i * 8192, R, C); const int Rb = Epi::PERM ? ((R & ~31) + perm32(R & 31)) : R;
        voffA[i] = g.blkA ? (unsigned)(tid * 16 + i * 8192) : (unsigned)(R * g.lda + C) * 2u; voffB[i] = g.blkB ? (unsigned)(tid * 16 + i * 8192) : (unsigned)(Rb * g.ldb + C) * 2u; }
    const size_t kstepA = g.blkA ? (size_t)(BM * BK * 2) : (size_t)(BK * 2), kstepB = g.blkB ? (size_t)(BM * BK * 2) : (size_t)(BK * 2);
    const size_t hstepA = (size_t)HALF * g.lda * 2, hstepB = (size_t)HALF * g.ldb * 2;
    const size_t tstepA = g.blkA ? (size_t)nt * (BM * BK * 2) : 2 * hstepA, tstepB = g.blkB ? (size_t)nt * (BM * BK * 2) : 2 * hstepB;
    const unsigned ldsw = (unsigned)wid * 1024u;
    const int aoff = lds_byte(wr * 64 + fr, fq * 8), boff = lds_byte(wc * 32 + fr, fq * 8);
#define PG8_SA(b, h) (((b) * 2 + (h)) * HTB)
#define PG8_SB(b, h) ((4 + (b) * 2 + (h)) * HTB)
#define PG8_STAGE(bufoff, gbase, voff) do { _Pragma("unroll") for (int _i = 0; _i < 2; ++_i) \
        __builtin_amdgcn_global_load_lds((const unsigned*)((const char*)(gbase) + (voff)[_i]), (PG8_LAS unsigned*)(lds + (bufoff) + ldsw + _i * 8192), 16, 0, 0); } while (0)
#define PG8_LDA(dst, b, h) do { _Pragma("unroll") for (int m = 0; m < 4; ++m) _Pragma("unroll") for (int k = 0; k < 2; ++k) dst[m][k] = *(const PG8_LAS bf16x8*)(lds + PG8_SA(b, h) + aoff + m * 2048 + k * 1024); } while (0)
#define PG8_LDB(dst, b, h) do { _Pragma("unroll") for (int n = 0; n < 2; ++n) _Pragma("unroll") for (int k = 0; k < 2; ++k) dst[n][k] = *(const PG8_LAS bf16x8*)(lds + PG8_SB(b, h) + boff + n * 2048 + k * 1024); } while (0)
#define PG8_MMA(ai, bj, At, Bt) do { __builtin_amdgcn_s_setprio(1); _Pragma("unroll") for (int k = 0; k < 2; ++k) _Pragma("unroll") for (int n = 0; n < 2; ++n) _Pragma("unroll") for (int m = 0; m < 4; ++m) \
        acc[ai][bj][m][n] = __builtin_amdgcn_mfma_f32_16x16x32_bf16(Bt[n][k], At[m][k], acc[ai][bj][m][n], 0, 0, 0); __builtin_amdgcn_s_setprio(0); } while (0)
#define PG8_WAIT_V(n) asm volatile("s_waitcnt vmcnt(" #n ")" ::: "memory")
#define PG8_WAIT_L(n) asm volatile("s_waitcnt lgkmcnt(" #n ")" ::: "memory")
#define PG8_BAR __builtin_amdgcn_s_barrier()
#define PG8_SCHED __builtin_amdgcn_sched_barrier(0)
    Unit cur, nxt; int ui = 0;
    if (!S.next(0, cur)) return;
    f32x4 acc[2][2][4][2];
#pragma unroll
    for (int a = 0; a < 2; ++a)
#pragma unroll
        for (int b = 0; b < 2; ++b)
#pragma unroll
            for (int m = 0; m < 4; ++m)
#pragma unroll
                for (int n = 0; n < 2; ++n) acc[a][b][m][n] = (f32x4){0.f, 0.f, 0.f, 0.f};
    bf16x8 At[4][2], B0[2][2], B1[2][2];
    const char* cA = (const char*)g.A + (size_t)cur.pm * tstepA; const char* cB = (const char*)g.Bt + (size_t)cur.pn * tstepB;
    S.a_ready(cur);
    if constexpr (SP2) {
        PG8_STAGE(PG8_SB(0, 0), cB, voffB); PG8_STAGE(PG8_SB(0, 1), cB + hstepB, voffB); PG8_STAGE(PG8_SA(0, 0), cA, voffA); PG8_STAGE(PG8_SA(0, 1), cA + hstepA, voffA);
        if (wr == 1) PG8_BAR;
        PG8_WAIT_V(2); PG8_BAR;
        PG8_STAGE(PG8_SB(1, 0), cB + kstepB, voffB); PG8_STAGE(PG8_SA(1, 0), cA + kstepA, voffA); PG8_STAGE(PG8_SB(1, 1), cB + hstepB + kstepB, voffB);
        PG8_WAIT_V(6); PG8_BAR;
    } else {
        PG8_STAGE(PG8_SB(0, 0), cB, voffB); PG8_STAGE(PG8_SA(0, 0), cA, voffA); PG8_STAGE(PG8_SB(0, 1), cB + hstepB, voffB); PG8_STAGE(PG8_SA(0, 1), cA + hstepA, voffA);
        if (wr == 1) PG8_BAR;
        PG8_WAIT_V(4); PG8_BAR;
        PG8_STAGE(PG8_SB(1, 0), cB + kstepB, voffB); PG8_STAGE(PG8_SA(1, 0), cA + kstepA, voffA); PG8_STAGE(PG8_SB(1, 1), cB + hstepB + kstepB, voffB);
        PG8_WAIT_V(6); PG8_BAR;
    }
    for (;;) {
        const bool has_next = S.next(ui + 1, nxt);
        const char* nA = has_next ? (const char*)g.A + (size_t)nxt.pm * tstepA : cA; const char* nB = has_next ? (const char*)g.Bt + (size_t)nxt.pn * tstepB : cB;
        for (int t = 0; t < nt; t += 2) {
            if constexpr (Epi::MIDK) { if (t == nt / 2) E.mid(acc, cur, wr, wc, fr, fq); }
            const bool last = (t == nt - 2);
            const char* a1 = cA + (size_t)(t + 1) * kstepA;
            const char* a2 = last ? nA : cA + (size_t)(t + 2) * kstepA; const char* b2 = last ? nB : cB + (size_t)(t + 2) * kstepB;
            const char* a3 = a2 + kstepA; const char* b3 = b2 + kstepB;
            if (last && has_next) S.a_ready(nxt);
            if constexpr (SP2) {
            PG8_LDB(B0, 0, 0); PG8_LDB(B1, 0, 1); PG8_SCHED; PG8_LDA(At, 0, 0); PG8_STAGE(PG8_SA(1, 1), a1 + hstepA, voffA);
            PG8_WAIT_V(8); PG8_WAIT_L(0); PG8_BAR; PG8_MMA(0, 0, At, B0); PG8_MMA(0, 1, At, B1); PG8_BAR; PG8_SCHED;
            PG8_LDA(At, 0, 1); PG8_STAGE(PG8_SB(0, 0), b2, voffB); PG8_STAGE(PG8_SB(0, 1), b2 + hstepB, voffB); PG8_STAGE(PG8_SA(0, 0), a2, voffA);
            PG8_WAIT_V(8); PG8_WAIT_L(0); PG8_BAR; PG8_MMA(1, 0, At, B0); PG8_MMA(1, 1, At, B1); PG8_BAR; PG8_SCHED;
            PG8_LDB(B0, 1, 0); PG8_LDB(B1, 1, 1); PG8_SCHED; PG8_LDA(At, 1, 0); PG8_STAGE(PG8_SA(0, 1), a2 + hstepA, voffA);
            PG8_WAIT_V(8); PG8_WAIT_L(0); PG8_BAR; PG8_MMA(0, 0, At, B0); PG8_MMA(0, 1, At, B1); PG8_BAR; PG8_SCHED;
            PG8_LDA(At, 1, 1); PG8_STAGE(PG8_SB(1, 0), b3, voffB); PG8_STAGE(PG8_SB(1, 1), b3 + hstepB, voffB); PG8_STAGE(PG8_SA(1, 0), a3, voffA);
            PG8_WAIT_V(8); PG8_WAIT_L(0); PG8_BAR; PG8_MMA(1, 0, At, B0); PG8_MMA(1, 1, At, B1); PG8_BAR; PG8_SCHED;
            } else {
            PG8_LDB(B0, 0, 0); PG8_SCHED; PG8_LDA(At, 0, 0); PG8_STAGE(PG8_SA(1, 1), a1 + hstepA, voffA);
            PG8_WAIT_L(8); PG8_BAR; PG8_WAIT_L(0); PG8_MMA(0, 0, At, B0); PG8_BAR; PG8_SCHED;
            PG8_LDB(B1, 0, 1); PG8_STAGE(PG8_SB(0, 0), b2, voffB);
            PG8_BAR; PG8_WAIT_L(0); PG8_MMA(0, 1, At, B1); PG8_BAR;
            PG8_LDA(At, 0, 1); PG8_STAGE(PG8_SA(0, 0), a2, voffA);
            PG8_BAR; PG8_WAIT_L(0); PG8_MMA(1, 0, At, B0); PG8_BAR; PG8_SCHED;
            PG8_STAGE(PG8_SB(0, 1), b2 + hstepB, voffB);
            PG8_WAIT_V(6); PG8_BAR; PG8_MMA(1, 1, At, B1); PG8_BAR;
            PG8_LDB(B0, 1, 0); PG8_SCHED; PG8_LDA(At, 1, 0); PG8_STAGE(PG8_SA(0, 1), a2 + hstepA, voffA);
            PG8_WAIT_L(8); PG8_BAR; PG8_WAIT_L(0); PG8_MMA(0, 0, At, B0); PG8_BAR; PG8_SCHED;
            PG8_LDB(B1, 1, 1); PG8_STAGE(PG8_SB(1, 0), b3, voffB);
            PG8_BAR; PG8_WAIT_L(0); PG8_MMA(0, 1, At, B1); PG8_BAR;
            PG8_LDA(At, 1, 1); PG8_STAGE(PG8_SA(1, 0), a3, voffA);
            PG8_BAR; PG8_WAIT_L(0); PG8_MMA(1, 0, At, B0); PG8_BAR; PG8_SCHED;
            PG8_STAGE(PG8_SB(1, 1), b3 + hstepB, voffB);
            PG8_WAIT_V(6); PG8_BAR; PG8_MMA(1, 1, At, B1); PG8_BAR;
            }
        }
        if constexpr (ALIGN_EPI) { if (wr == 0) PG8_BAR; }
        if constexpr (!Epi::AFTER_DRAIN) { E(acc, cur, wr, wc, fr, fq); S.done(cur); }
        if (!has_next) break;
#pragma unroll
        for (int a = 0; a < 2; ++a)
#pragma unroll
            for (int b = 0; b < 2; ++b)
#pragma unroll
                for (int m = 0; m < 4; ++m)
#pragma unroll
                    for (int n = 0; n < 2; ++n) acc[a][b][m][n] = (f32x4){0.f, 0.f, 0.f, 0.f};
        cur = nxt; cA = nA; cB = nB; ++ui;
        if constexpr (ALIGN_EPI) { if (wr == 1) PG8_BAR; }
    }
    PG8_WAIT_V(0);
    if constexpr (!ALIGN_EPI) { if (wr == 0) PG8_BAR; }
    PG8_BAR;
    if constexpr (Epi::AFTER_DRAIN) { E.fused(acc, cur, wr, wc, fr, fq, lds, wid, lane); S.done(cur); }
#undef PG8_SA
#undef PG8_SB
#undef PG8_STAGE
#undef PG8_LDA
#undef PG8_LDB
#undef PG8_MMA
#undef PG8_WAIT_V
#undef PG8_WAIT_L
#undef PG8_BAR
#undef PG8_SCHED
}
__device__ __forceinline__ u32x4 pack8(const f32x4 v0, const f32x4 v1) { u32x4 w; w.x = cvt_pk_bf16(v0[0], v0[1]); w.y = cvt_pk_bf16(v0[2], v0[3]); w.z = cvt_pk_bf16(v1[0], v1[1]); w.w = cvt_pk_bf16(v1[2], v1[3]); return w; }
__device__ __forceinline__ float bflo(unsigned w) { return __builtin_bit_cast(float, w << 16); }
__device__ __forceinline__ float bfhi(unsigned w) { return __builtin_bit_cast(float, w & 0xffff0000u); }
__device__ __forceinline__ size_t blk_off(int pm, int nkt, int kt, int r, int c) { return ((size_t)pm * nkt + kt) * (BM * BK) + img_in(r, c); }
__device__ __forceinline__ float relu1(float x) { float r; asm("v_max_f32_e32 %0, 0, %1" : "=v"(r) : "v"(x)); return r; }
__device__ __forceinline__ float sq4(const f32x4 x) { return (x[0] * x[0] + x[1] * x[1]) + (x[2] * x[2] + x[3] * x[3]); }

struct EpiProj {
    static constexpr bool PERM = true, AFTER_DRAIN = false, MIDK = false;
    bf16_t* Q; bf16_t* Kb; bf16_t* V; bf16_t* X3; float* kmean; const float* qg; const float* kg;
    __device__ __forceinline__ void operator()(const f32x4 (&acc)[2][2][4][2], const Unit& u, int wr, int wc, int fr, int fq) const {
        const int pn = u.pn;
        const int row0 = u.pm * BM + wr * 64 + fr;
        if (pn < 8) {
            const bool isq = pn < 4;
            const float* gp = isq ? qg : kg; const float gs = isq ? QSCALE : 1.0f;
            f32x4 gv[2][2];
#pragma unroll
            for (int bj = 0; bj < 2; ++bj)
#pragma unroll
                for (int n = 0; n < 2; ++n) gv[bj][n] = *(const f32x4*)(gp + 32 * bj + 8 * fq + 4 * n) * gs;
            const int head = (pn & 3) * 4 + wc;
            bf16_t* base = (isq ? Q : Kb) + head * 64 + 8 * fq;
            f32x4 cs[2][2];
#pragma unroll
            for (int bj = 0; bj < 2; ++bj)
#pragma unroll
                for (int n = 0; n < 2; ++n) cs[bj][n] = (f32x4){0.f, 0.f, 0.f, 0.f};
#pragma unroll
            for (int ai = 0; ai < 2; ++ai)
#pragma unroll
                for (int m = 0; m < 4; ++m) {
                    float ss = 0.f;
#pragma unroll
                    for (int bj = 0; bj < 2; ++bj)
#pragma unroll
                        for (int n = 0; n < 2; ++n) ss += sq4(acc[ai][bj][m][n]);
                    ss += shx<16>(ss); ss = xsum32(ss);
                    const float rn = rsqrtf(ss * (1.0f / 64.0f) + EPS);
                    const int tq = (u.pm & 7) * BM + ai * HALF + wr * 64 + m * 16 + fr;
                    bf16_t* rowp = isq ? base + (size_t)(row0 + ai * HALF + m * 16) * AW
                                       : Kb + ((size_t)(((u.pm >> 3) * NH + head) * (SEQ / 64) + (tq >> 6)) * 8 + fq) * 512 + (tq & 63) * 8;
#pragma unroll
                    for (int bj = 0; bj < 2; ++bj) {
                        const f32x4 v0 = acc[ai][bj][m][0] * rn * gv[bj][0], v1 = acc[ai][bj][m][1] * rn * gv[bj][1];
                        cs[bj][0] += v0; cs[bj][1] += v1;
                        *(u32x4*)(rowp + (isq ? 32 * bj : 2048 * bj)) = pack8(v0, v1);
                    }
                }
            if (!isq) {
                float* km = kmean + ((size_t)((u.pm >> 3) * NH + head) * NBLK + (u.pm & 7)) * HD + 8 * fq;
#pragma unroll
                for (int bj = 0; bj < 2; ++bj)
#pragma unroll
                    for (int n = 0; n < 2; ++n)
#pragma unroll
                        for (int e = 0; e < 4; ++e) {
                            float v = cs[bj][n][e];
                            v += shx<1>(v); v += shx<2>(v); v += shx<4>(v); v += shx<8>(v);
                            if (fr == 0) __hip_atomic_fetch_add(km + 32 * bj + 4 * n + e, v, __ATOMIC_RELAXED, __HIP_MEMORY_SCOPE_AGENT);
                        }
            }
        } else if (pn < 12) {
#pragma unroll
            for (int ai = 0; ai < 2; ++ai)
#pragma unroll
                for (int m = 0; m < 4; ++m) {
                    const int tq = (u.pm & 7) * BM + ai * HALF + wr * 64 + m * 16 + fr;
#pragma unroll
                    for (int bj = 0; bj < 2; ++bj) { const int head = (pn - 8) * 4 + 2 * bj + (wc >> 1);
                        *(u32x4*)(V + ((size_t)(((u.pm >> 3) * NH + head) * (SEQ / 64) + (tq >> 6)) * 8 + (wc & 1) * 4 + ((tq >> 4) & 3)) * 512 + (tq & 15) * 32 + 8 * fq) = pack8(acc[ai][bj][m][0], acc[ai][bj][m][1]); }
                }
        } else {
            const int b = u.pm >> 3;
#pragma unroll
            for (int bj = 0; bj < 2; ++bj) {
                const int ch = (pn - 12) * 256 + bj * HALF + wc * 32 + 8 * fq, g = ch >> 4, h0 = ch & 15;
#pragma unroll
                for (int ai = 0; ai < 2; ++ai)
#pragma unroll
                    for (int m = 0; m < 4; ++m) {
                        const int c16 = (u.pm & 7) * 16 + ai * 8 + wr * 4 + m;
                        bf16_t* p = X3 + ((size_t)(g * (BATCH * NCH) + b * NCH + c16)) * X3LD + fr * SC + h0;
                        *(u32x4*)p = pack8(acc[ai][bj][m][0], acc[ai][bj][m][1]);
                    }
            }
        }
    }
};

struct EpiGlu {
    static constexpr bool PERM = true, AFTER_DRAIN = false, MIDK = false;
    const bf16_t* act; bf16_t* out; const float* bias; float* rowsq;
    __device__ __forceinline__ void operator()(const f32x4 (&acc)[2][2][4][2], const Unit& u, int wr, int wc, int fr, int fq) const {
        const int row0 = u.pm * BM + wr * 64 + fr, col0 = u.pn * BM + wc * 32 + 8 * fq;
        f32x4 bv[2][2]; u32x4 av[2][4][2];
#pragma unroll
        for (int bj = 0; bj < 2; ++bj)
#pragma unroll
            for (int n = 0; n < 2; ++n) bv[bj][n] = *(const f32x4*)(bias + col0 + bj * HALF + 4 * n);
#pragma unroll
        for (int ai = 0; ai < 2; ++ai)
#pragma unroll
            for (int m = 0; m < 4; ++m) { const size_t offa = blk_off(u.pm, SW / BK, 4 * u.pn + (wc >> 1), ai * HALF + wr * 64 + m * 16 + fr, 32 * (wc & 1) + 8 * fq);
#pragma unroll
                for (int bj = 0; bj < 2; ++bj) av[ai][m][bj] = *(const u32x4*)(act + offa + (size_t)bj * 2 * BM * BK); }
        asm volatile("" ::: "memory");
#pragma unroll
        for (int ai = 0; ai < 2; ++ai)
#pragma unroll
            for (int m = 0; m < 4; ++m) {
                const int row = row0 + ai * HALF + m * 16;
                const size_t off = blk_off(u.pm, DM / BK, AW / BK + 4 * u.pn + (wc >> 1), row - u.pm * BM, 32 * (wc & 1) + 8 * fq);
                float ss = 0.f;
#pragma unroll
                for (int bj = 0; bj < 2; ++bj) {
                    const u32x4 a = av[ai][m][bj];
                    const f32x4 a0 = (f32x4){bflo(a.x), bfhi(a.x), bflo(a.y), bfhi(a.y)}, a1 = (f32x4){bflo(a.z), bfhi(a.z), bflo(a.w), bfhi(a.w)};
                    const f32x4 g0 = (acc[ai][bj][m][0] + bv[bj][0]) * (-LOG2E), g1 = (acc[ai][bj][m][1] + bv[bj][1]) * (-LOG2E);
                    f32x4 o0, o1;
#pragma unroll
                    for (int e = 0; e < 4; ++e) { o0[e] = a0[e] * __builtin_amdgcn_rcpf(1.0f + __builtin_amdgcn_exp2f(g0[e])); o1[e] = a1[e] * __builtin_amdgcn_rcpf(1.0f + __builtin_amdgcn_exp2f(g1[e])); }
                    const u32x4 w = pack8(o0, o1);
                    *(u32x4*)(out + off + (size_t)bj * 2 * BM * BK) = w;
                    ss += (bflo(w.x) * bflo(w.x) + bfhi(w.x) * bfhi(w.x)) + (bflo(w.y) * bflo(w.y) + bfhi(w.y) * bfhi(w.y)) + (bflo(w.z) * bflo(w.z) + bfhi(w.z) * bfhi(w.z)) + (bflo(w.w) * bflo(w.w) + bfhi(w.w) * bfhi(w.w));
                }
                ss += shx<16>(ss); ss = xsum32(ss);
                if (fq == 0) __hip_atomic_fetch_add(rowsq + row, ss, __ATOMIC_RELAXED, __HIP_MEMORY_SCOPE_AGENT);
            }
    }
};

struct EpiWout {
    static constexpr bool PERM = true, AFTER_DRAIN = false, MIDK = true;
    const float* x; bf16_t* x1b; float* rowsq; const float* sqa; const float* sqs;
    __device__ __forceinline__ void mid(f32x4 (&acc)[2][2][4][2], const Unit& u, int wr, int wc, int fr, int fq) const {
        int row0 = u.pm * BM + wr * 64 + fr; asm volatile("" : "+v"(row0));
#pragma unroll
        for (int ai = 0; ai < 2; ++ai)
#pragma unroll
            for (int m = 0; m < 4; ++m) { const int row = row0 + ai * HALF + m * 16;
                const float f = rsqrtf(sqa[row] * (1.0f / (float)AW) + EPS) * sqrtf(sqs[row] * (1.0f / (float)SW) + EPS);
#pragma unroll
                for (int bj = 0; bj < 2; ++bj)
#pragma unroll
                    for (int n = 0; n < 2; ++n) acc[ai][bj][m][n] *= f; }
    }
    __device__ __forceinline__ void operator()(const f32x4 (&acc)[2][2][4][2], const Unit& u, int wr, int wc, int fr, int fq) const {
        const int row0 = u.pm * BM + wr * 64 + fr, col0 = u.pn * BM + wc * 32 + 8 * fq;
        float rs[2][4];
#pragma unroll
        for (int ai = 0; ai < 2; ++ai)
#pragma unroll
            for (int m = 0; m < 4; ++m) rs[ai][m] = rsqrtf(sqs[row0 + ai * HALF + m * 16] * (1.0f / (float)SW) + EPS);
#pragma unroll
        for (int ai = 0; ai < 2; ++ai) {
            f32x4 xv[4][2][2];
#pragma unroll
            for (int m = 0; m < 4; ++m) { const size_t off = (size_t)(row0 + ai * HALF + m * 16) * DM + col0;
#pragma unroll
                for (int bj = 0; bj < 2; ++bj) { xv[m][bj][0] = *(const f32x4*)(x + off + bj * HALF); xv[m][bj][1] = *(const f32x4*)(x + off + bj * HALF + 4); } }
            asm volatile("" ::: "memory");
#pragma unroll
            for (int m = 0; m < 4; ++m) {
                const int row = row0 + ai * HALF + m * 16; const size_t offb = blk_off(u.pm, DM / BK, 4 * u.pn + (wc >> 1), row - u.pm * BM, 32 * (wc & 1) + 8 * fq);
                float ss = 0.f;
#pragma unroll
                for (int bj = 0; bj < 2; ++bj) {
                    const f32x4 v0 = acc[ai][bj][m][0] * rs[ai][m] + xv[m][bj][0], v1 = acc[ai][bj][m][1] * rs[ai][m] + xv[m][bj][1];
                    *(u32x4*)(x1b + offb + (size_t)bj * 2 * BM * BK) = pack8(v0, v1);
                    ss += sq4(v0) + sq4(v1);
                }
                ss += shx<16>(ss); ss = xsum32(ss);
                if (fq == 0) __hip_atomic_fetch_add(rowsq + row, ss, __ATOMIC_RELAXED, __HIP_MEMORY_SCOPE_AGENT);
            }
            asm volatile("" ::: "memory");
        }
    }
};

struct EpiFF1 {
    static constexpr bool PERM = true, AFTER_DRAIN = false, MIDK = false;
    bf16_t* hid; const float* rowsq;
    __device__ __forceinline__ void operator()(const f32x4 (&acc)[2][2][4][2], const Unit& u, int wr, int wc, int fr, int fq) const {
        const int row0 = u.pm * BM + wr * 64 + fr;
        float r2[2][4];
#pragma unroll
        for (int ai = 0; ai < 2; ++ai)
#pragma unroll
            for (int m = 0; m < 4; ++m) r2[ai][m] = __builtin_amdgcn_rcpf(rowsq[row0 + ai * HALF + m * 16] * (1.0f / (float)DM) + EPS);
        asm volatile("" ::: "memory");
#pragma unroll
        for (int ai = 0; ai < 2; ++ai)
#pragma unroll
            for (int m = 0; m < 4; ++m) {
                bf16_t* rowp = hid + blk_off(u.pm, DFF / BK, 4 * u.pn + wc, ai * HALF + wr * 64 + m * 16 + fr, 8 * fq);
#pragma unroll
                for (int bj = 0; bj < 2; ++bj) {
                    f32x4 v0 = acc[ai][bj][m][0], v1 = acc[ai][bj][m][1];
#pragma unroll
                    for (int e = 0; e < 4; ++e) { v0[e] = relu1(v0[e]); v1[e] = relu1(v1[e]); }
                    v0 = (v0 * v0) * r2[ai][m]; v1 = (v1 * v1) * r2[ai][m];
                    *(u32x4*)(rowp + 512 * bj) = pack8(v0, v1);
                }
            }
    }
};

struct EpiFF2 {
    static constexpr bool PERM = true, AFTER_DRAIN = false, MIDK = false;
    float* out; const bf16_t* x1b;
    __device__ __forceinline__ void operator()(const f32x4 (&acc)[2][2][4][2], const Unit& u, int wr, int wc, int fr, int fq) const {
        const int row0 = u.pm * BM + wr * 64 + fr, col0 = u.pn * BM + wc * 32 + 8 * fq;
        u32x4 av[2][4][2];
#pragma unroll
        for (int ai = 0; ai < 2; ++ai)
#pragma unroll
            for (int m = 0; m < 4; ++m) { const bf16_t* xp = x1b + blk_off(u.pm, DM / BK, 4 * u.pn + (wc >> 1), ai * HALF + wr * 64 + m * 16 + fr, 32 * (wc & 1) + 8 * fq);
#pragma unroll
                for (int bj = 0; bj < 2; ++bj) av[ai][m][bj] = *(const u32x4*)(xp + (size_t)bj * 2 * BM * BK); }
        asm volatile("" ::: "memory");
#pragma unroll
        for (int ai = 0; ai < 2; ++ai)
#pragma unroll
            for (int m = 0; m < 4; ++m) {
                float* rowp = out + (size_t)(row0 + ai * HALF + m * 16) * DM + col0;
#pragma unroll
                for (int bj = 0; bj < 2; ++bj) { const u32x4 a = av[ai][m][bj];
                    *(f32x4*)(rowp + bj * HALF) = acc[ai][bj][m][0] + (f32x4){bflo(a.x), bfhi(a.x), bflo(a.y), bfhi(a.y)};
                    *(f32x4*)(rowp + bj * HALF + 4) = acc[ai][bj][m][1] + (f32x4){bflo(a.z), bfhi(a.z), bflo(a.w), bfhi(a.w)}; }
            }
    }
};

struct GroupOrder {
    int G, c;
    __device__ __forceinline__ bool next(int i, Unit& u) const { const int n = i * G + c; if (n >= SG * 8) return false; u.pm = n; u.pn = n >> 3; return true; }
    __device__ __forceinline__ void a_ready(const Unit&) const {}
    __device__ __forceinline__ void done(const Unit&) const {}
};
struct EpiSsmL {
    static constexpr bool PERM = false, AFTER_DRAIN = false, MIDK = false;
    float* L;
    __device__ __forceinline__ void operator()(const f32x4 (&acc)[2][2][4][2], const Unit& u, int wr, int wc, int fr, int fq) const {
        const int row0 = u.pm * BM + wr * 64 + fr, col0 = wc * 32 + 4 * fq;
#pragma unroll
        for (int ai = 0; ai < 2; ++ai)
#pragma unroll
            for (int m = 0; m < 4; ++m) { float* rowp = L + (size_t)(row0 + ai * HALF + m * 16) * (2 * SP) + col0;
#pragma unroll
                for (int n = 0; n < 2; ++n) *(f32x4*)(rowp + n * 16) = acc[ai][0][m][n]; }
    }
};
__device__ __forceinline__ float gelu_tanh_e(float y) { const float z = y * (1.0f + 0.044715f * y * y) * (-2.0f * 0.7978845608028654f * LOG2E); return y * __builtin_amdgcn_rcpf(1.0f + __builtin_amdgcn_exp2f(z)); }
struct EpiSsmY {
    static constexpr bool PERM = true, AFTER_DRAIN = false, MIDK = false;
    bf16_t* ACT;
    __device__ __forceinline__ void operator()(const f32x4 (&acc)[2][2][4][2], const Unit& u, int wr, int wc, int fr, int fq) const {
        const int g = u.pn, rloc0 = (u.pm & 7) * BM + wr * 64 + fr;
        int cpart[2];
#pragma unroll
        for (int bj = 0; bj < 2; ++bj) { const int col = bj * HALF + wc * 32 + 8 * fq, i = col >> 4, cin = (g & 3) * SC + (col & 15);
            cpart[bj] = (cin >> 5) * 512 + (((i * 64 + (cin & 31) * 2) ^ (((i >> 3) & 1) << 5)) >> 1); }
#pragma unroll
        for (int ai = 0; ai < 2; ++ai)
#pragma unroll
            for (int m = 0; m < 4; ++m) { int rl = rloc0 + ai * HALF + m * 16; asm volatile("" : "+v"(rl));
                const int b = rl >> 7, c = rl & 127;
                bf16_t* base = ACT + ((size_t)(b * 8 + (c >> 4)) * (SW / BK) + (g >> 2)) * (BM * BK) + ((c >> 3) & 1) * 8192 + (c & 7) * 1024;
#pragma unroll
                for (int bj = 0; bj < 2; ++bj) {
                    f32x4 v0 = acc[ai][bj][m][0], v1 = acc[ai][bj][m][1];
#pragma unroll
                    for (int e2 = 0; e2 < 4; ++e2) { v0[e2] = gelu_tanh_e(v0[e2]); v1[e2] = gelu_tanh_e(v1[e2]); }
                    *(u32x4*)(base + cpart[bj]) = pack8(v0, v1); } }
    }
};
}
#include <hip/hip_bf16.h>
#include <cmath>
namespace attn_body {
using bf16=__hip_bfloat16;
using bf16x8=__attribute__((ext_vector_type(8)))short;
using s16x4=__attribute__((ext_vector_type(4)))short;
using f32x16=__attribute__((ext_vector_type(16)))float;
using u32x4=__attribute__((ext_vector_type(4)))unsigned;
using f32x4v=__attribute__((ext_vector_type(4)))float;
constexpr int BATCH=16,NHEAD=16,SEQ=2048,D=64,DM=NHEAD*D;
constexpr int NW=8,QBLK=32,QB=QBLK*NW,KVBLK=64,NQB=SEQ/QB;
constexpr int ATTN_PITCH=DM, ATTN_UNIT_ROWS=QB, OPITCH=2048+64;
__device__ __forceinline__ int crow(int r,int hi){return (r&3)+8*(r>>2)+4*hi;}
#define SBAR() __builtin_amdgcn_sched_barrier(0)
__device__ __forceinline__ void cmask(f32x16&p0,f32x16&p1,int jb,int qrel,int hi){
  const float NEG=-4096.0f; int kb=64*jb+4*hi;
  #pragma unroll
  for(int r=0;r<16;++r){int kv=kb+(r&3)+8*(r>>2); if(kv>qrel)p0[r]=NEG; if(kv+32>qrel)p1[r]=NEG;}
}

constexpr int NSLOT=3, SLOTB=8192;
constexpr int LDS_K=0, LDS_V=NSLOT*SLOTB, LDS_WS=2*NSLOT*SLOTB, LDS_OST=LDS_WS+NW*64*4, LDS_BYTES=LDS_OST+NW*4096;
constexpr float C2=0.125f*1.4426950408889634f;
__device__ __forceinline__ void glds16(const void*gsrc,unsigned lds_dst){unsigned keep;
  asm volatile("s_mov_b32 %0, m0\n\ts_mov_b32 m0, %2\n\ts_nop 0\n\tglobal_load_lds_dwordx4 %1, off\n\ts_mov_b32 m0, %0":"=&s"(keep):"v"(gsrc),"s"(lds_dst):"memory");}
__device__ __forceinline__ float max3f(float a,float b,float c){float r;asm("v_max3_f32 %0, %1, %2, %3":"=v"(r):"v"(a),"v"(b),"v"(c));return r;}
__device__ __forceinline__ float max2f(float a,float b){float r;asm("v_max_f32_e32 %0, %1, %2":"=v"(r):"v"(a),"v"(b));return r;}
__device__ __forceinline__ float fadd_s(float a,float b){float r;asm("v_add_f32_e32 %0, %1, %2":"=v"(r):"v"(a),"v"(b));return r;}
__device__ __forceinline__ float fsub_s(float a,float b){float r;asm("v_sub_f32_e32 %0, %1, %2":"=v"(r):"v"(a),"v"(b));return r;}
typedef float f32x2_t __attribute__((ext_vector_type(2))); typedef __bf16 bf16x2_t __attribute__((ext_vector_type(2)));
__device__ __forceinline__ unsigned cvtpk_s(float lo,float hi){f32x2_t v={lo,hi};bf16x2_t b=__builtin_convertvector(v,bf16x2_t);return __builtin_bit_cast(unsigned,b);}
#define WAIT_BAR(N) asm volatile("s_waitcnt vmcnt(" #N ") lgkmcnt(0)\n\ts_barrier":::"memory")

__device__ __forceinline__ void qkt(f32x16&p0,f32x16&p1,const char*Kslot,const bf16x8*qr,int r32,int hi){
  const char*kb=Kslot+hi*1024+r32*16;
  #pragma unroll
  for(int d0=0;d0<4;++d0){
    const bf16x8 b0=*reinterpret_cast<const bf16x8*>(kb+d0*2048);
    const bf16x8 b1=*reinterpret_cast<const bf16x8*>(kb+d0*2048+512);
    p0=__builtin_amdgcn_mfma_f32_32x32x16_bf16(b0,qr[d0],p0,0,0,0);p1=__builtin_amdgcn_mfma_f32_32x32x16_bf16(b1,qr[d0],p1,0,0,0);}
}
typedef __attribute__((address_space(3))) const char* lds_cptr;
typedef short v4i16_t __attribute__((ext_vector_type(4)));
__device__ __forceinline__ void kload8(bf16x8*kf,lds_cptr kp){
  kf[0]=*(const __attribute__((address_space(3))) bf16x8*)(kp);      kf[1]=*(const __attribute__((address_space(3))) bf16x8*)(kp+512);
  kf[2]=*(const __attribute__((address_space(3))) bf16x8*)(kp+2048); kf[3]=*(const __attribute__((address_space(3))) bf16x8*)(kp+2560);
  kf[4]=*(const __attribute__((address_space(3))) bf16x8*)(kp+4096); kf[5]=*(const __attribute__((address_space(3))) bf16x8*)(kp+4608);
  kf[6]=*(const __attribute__((address_space(3))) bf16x8*)(kp+6144); kf[7]=*(const __attribute__((address_space(3))) bf16x8*)(kp+6656);
}
__device__ __forceinline__ void kload2(bf16x8*kf,lds_cptr kp,int j){ kf[2*j]=*(const __attribute__((address_space(3))) bf16x8*)(kp+j*2048); kf[2*j+1]=*(const __attribute__((address_space(3))) bf16x8*)(kp+j*2048+512); }
__device__ __forceinline__ s16x4 vtr(lds_cptr p){ return __builtin_bit_cast(s16x4,__builtin_amdgcn_ds_read_tr16_b64_v4i16((__attribute__((address_space(3))) v4i16_t*)p)); }
__device__ __forceinline__ float rowmax(const f32x16&p0,const f32x16&p1){
  float a=max3f(p0[0],p0[1],p1[0]),b=max3f(p0[2],p0[3],p1[1]);a=max3f(a,p1[2],p1[3]);
  #pragma unroll
  for(int r=4;r<16;r+=4){a=max3f(a,p0[r],p0[r+1]);b=max3f(b,p0[r+2],p0[r+3]);a=max3f(a,p1[r],p1[r+1]);b=max3f(b,p1[r+2],p1[r+3]);}
  const float m=max2f(a,b);
  auto rr=__builtin_amdgcn_permlane32_swap(__float_as_uint(m),__float_as_uint(m),false,false);
  return max2f(__uint_as_float(rr[0]),__uint_as_float(rr[1]));
}
__device__ __forceinline__ void pv(f32x16*o,int vb,bf16x8 pa0,bf16x8 pa1,bf16x8 pa2,bf16x8 pa3){
  #pragma unroll
  for(int d0=0;d0<2;++d0){s16x4 lo[4],hi[4];
    #pragma unroll
    for(int ks=0;ks<4;++ks){
      asm volatile("ds_read_b64_tr_b16 %0,%1 offset:%c2":"=&v"(lo[ks]):"v"(vb),"i"(d0*4096+ks*1024):"memory");
      asm volatile("ds_read_b64_tr_b16 %0,%1 offset:%c2":"=&v"(hi[ks]):"v"(vb),"i"(d0*4096+ks*1024+512):"memory");}
    asm volatile("s_waitcnt lgkmcnt(0)":::"memory");SBAR();
    #define PK(k) (bf16x8){lo[k][0],lo[k][1],lo[k][2],lo[k][3],hi[k][0],hi[k][1],hi[k][2],hi[k][3]}
    o[d0]=__builtin_amdgcn_mfma_f32_32x32x16_bf16(pa0,PK(0),o[d0],0,0,0);
    o[d0]=__builtin_amdgcn_mfma_f32_32x32x16_bf16(pa1,PK(1),o[d0],0,0,0);
    o[d0]=__builtin_amdgcn_mfma_f32_32x32x16_bf16(pa2,PK(2),o[d0],0,0,0);
    o[d0]=__builtin_amdgcn_mfma_f32_32x32x16_bf16(pa3,PK(3),o[d0],0,0,0);
    #undef PK
  }
}

#ifndef ATTN_STORE16
#define ATTN_STORE16(p,v) (*(u32x4*)(p)=(v))
#endif
template<int THRL> __device__ __forceinline__ void attn_unit(int b,int h,int qb,const bf16*Q,const bf16*__restrict__ K,const bf16*__restrict__ V,bf16*O,const float*kmean,float*rowsq,char*shm,bool pref,bool hn,int nb,int nh,int nqb,bf16x8(&qn)[4]){
  int tid_=threadIdx.x; asm volatile("":"+v"(tid_)); const int tid=tid_,lane=tid&63,r32=lane&31,hi=lane>>5; const int wid=__builtin_amdgcn_readfirstlane(tid>>6);
  const long rowbase=(long)b*SEQ; const int q0=qb*QB;
  const bf16*Qw=Q+(rowbase+q0+wid*QBLK)*DM+h*D;
  const bf16*Kh=K+(long)(b*NHEAD+h)*(SEQ*D),*Vh=V+(long)(b*NHEAD+h)*(SEQ*D);
  const unsigned lds0=(unsigned)(uintptr_t)shm;
  float*wsf=(float*)(shm+LDS_WS)+wid*64;
  const bf16*ksrc=Kh+wid*512+lane*8;
  const bf16*vsrc=Vh+wid*512+lane*8;
  const unsigned kdst=lds0+LDS_K+wid*1024, vdst=lds0+LDS_V+wid*1024;
  #define DMA_K(t,slot) glds16(ksrc+(long)(NTF-1-(t))*(KVBLK*D),(unsigned)__builtin_amdgcn_readfirstlane(kdst+(slot)))
  #define DMA_V(t,slot) glds16(vsrc+(long)(NTF-1-(t))*(KVBLK*D),(unsigned)__builtin_amdgcn_readfirstlane(vdst+(slot)))
  const int vb0=(int)(lds0+LDS_V)+((lane>>4)&1)*32+(lane&3)*8+(4*hi+((lane&15)>>2))*64;
  const char*Kbase=shm+LDS_K; bf16x8 kf[8];
  const lds_cptr shm3=(lds_cptr)shm; const lds_cptr kp0=shm3+LDS_K+hi*1024+r32*16; const lds_cptr vp0=shm3+LDS_V+((lane>>4)&1)*32+(lane&3)*8+(4*hi+((lane&15)>>2))*64;
  const float sl2=__builtin_amdgcn_exp2f(-0.5f*(float)(h+1))*1.4426950408889634f;
  const int NTF=(q0+QB)/KVBLK;
  int npt_=(int)((182.0f/sl2+63.0f)*(1.0f/64.0f)); npt_+=npt_&1; npt_=__builtin_amdgcn_readfirstlane(npt_);
  const int NT=(4+npt_<NTF)?4+npt_:NTF;
  if(!pref){DMA_K(0,0);DMA_V(0,0);DMA_K(1,SLOTB);}
  bf16x8 qr[4];
  #pragma unroll
  for(int d0=0;d0<4;++d0)qr[d0]=pref?qn[d0]:*reinterpret_cast<const bf16x8*>(&Qw[(long)r32*DM+d0*16+hi*8]);
  float mhat=0.f,l_reg=0.f;f32x16 o[2];o[0]=f32x16{};o[1]=f32x16{};
  unsigned selm=0u;
  if(qb>0){ float gate[7];
    #pragma unroll
    for(int j=0;j<7;++j){ float sg=0.f;
      if(j<qb){ const float*km=kmean+((long)(b*NHEAD+h)*8+j)*D+hi*8;
        #pragma unroll
        for(int d0=0;d0<4;++d0){ const f32x4v ka=*reinterpret_cast<const f32x4v*>(km+d0*16),kb2=*reinterpret_cast<const f32x4v*>(km+d0*16+4); const bf16x8 qv=qr[d0];
          #define QF(i) __builtin_bit_cast(float,((unsigned)(unsigned short)qv[i])<<16)
          sg+=(QF(0)*ka[0]+QF(1)*ka[1])+(QF(2)*ka[2]+QF(3)*ka[3])+(QF(4)*kb2[0]+QF(5)*kb2[1])+(QF(6)*kb2[2]+QF(7)*kb2[3]);
          #undef QF
        }
        sg=xsum32(sg); }
      gate[j]=sg; }
    #pragma unroll
    for(int j=0;j<7;++j) if(j<qb){ int cnt=0;
      #pragma unroll
      for(int i=0;i<7;++i) if(i!=j&&i<qb) cnt+=(gate[i]>gate[j]||(gate[i]==gate[j]&&i<j))?1:0;
      if(cnt<3) selm|=1u<<j; } }
  const float hib=sl2*(float)(4*hi);
  #define CINIT(C0,C1,t) do{ const int t_=(t); const bool on_=(t_<4)||(((selm>>((NTF-1-t_)>>2))&1u)!=0u); \
    const float bs_=on_?(sl2*(float)(64*(3-t_))+hib-mhat):-4096.0f; \
    const f32x2_t sv_={sl2,sl2},bv_={bs_,bs_},dv_={32.0f*sl2,32.0f*sl2}; \
    _Pragma("unroll") for(int r=0;r<16;r+=2){ const float kc_=(float)((r&3)+8*(r>>2)); const f32x2_t kk_={kc_,kc_+1.0f}; const f32x2_t r0_=sv_*kk_+bv_, r1_=r0_+dv_; \
      C0[r]=r0_.x; C0[r+1]=r0_.y; C1[r]=r1_.x; C1[r+1]=r1_.y; } }while(0)
  const int qrel=wid*QBLK+r32;
  #define CMASK(P0,P1,t) do{int jb_=3-(t); if(jb_>=0)cmask(P0,P1,jb_,qrel,hi);}while(0)
  bool resc=false;
  #define START(P0,P1) do{ const float rm=rowmax(P0,P1); resc=false; \
    { const float dl=rm; mhat=fadd_s(mhat,dl); \
      _Pragma("unroll") for(int r=0;r<16;++r){P0[r]=fsub_s(P0[r],dl);P1[r]=fsub_s(P1[r],dl);} \
      } \
    _Pragma("unroll") for(int r=0;r<16;++r)P0[r]=__builtin_amdgcn_exp2f(P0[r]); }while(0)
  #define RESC() do{ if(resc){ asm volatile("s_waitcnt lgkmcnt(0)":::"memory"); \
      _Pragma("unroll") for(int d_=0;d_<2;++d_) _Pragma("unroll") for(int r=0;r<16;++r)o[d_][r]*=wsf[crow(r,hi)]; } }while(0)
  f32x16 pA0,pA1,pB0,pB1;
  int sl_prev=0,sl_cur=0,sl_next=SLOTB;
  #define ROT() do{sl_prev=sl_cur;sl_cur=sl_next;sl_next=(sl_next==(NSLOT-1)*SLOTB)?0:sl_next+SLOTB;}while(0)
  DMA_K(2,2*SLOTB);
  WAIT_BAR(3);
  CINIT(pA0,pA1,0);qkt(pA0,pA1,Kbase,qr,r32,hi);asm volatile("s_nop 15\n\ts_nop 7":"+v"(pA0),"+v"(pA1));CMASK(pA0,pA1,0);
  START(pA0,pA1);
  _Pragma("unroll") for(int r=0;r<16;++r)pA1[r]=__builtin_amdgcn_exp2f(pA1[r]);
  WAIT_BAR(0);
  DMA_K(3,0);DMA_V(1,SLOTB);
  ROT();
  kload8(kf,kp0+sl_cur);
  WAIT_BAR(2);
  s16x4 vlo[8],vhi[8]; u32x4 pw0,pw1,pw2,pw3;
  #define PKW(P,B) cvtpk_s(P[B],P[B+1])
  #define PAF(k) __builtin_bit_cast(bf16x8,pw##k)
  #define VFR(i) (bf16x8){vlo[i][0],vlo[i][1],vlo[i][2],vlo[i][3],vhi[i][0],vhi[i][1],vhi[i][2],vhi[i][3]}
  #define PIN(x) asm volatile("":"+v"(x))
  #define MX3(a,b,c) __builtin_fmaxf(__builtin_fmaxf((a),(b)),(c))
  #define GAPA(MF,A0,A1,A2,A3,W0,W1,PW) do{ MF; sacc+=A0; sacc+=A1; sacc+=A2; sacc+=A3; PIN(sacc); W0; W1; PIN(PW); SBAR(); }while(0)
  #define EX(v) __builtin_amdgcn_exp2f(v)
  #define GAPB(MF,X,B) do{ MF; X[B]=EX(X[B]); X[B+1]=EX(X[B+1]); X[B+2]=EX(X[B+2]); X[B+3]=EX(X[B+3]); PIN(X); SBAR(); }while(0)
  #define VRD(i) do{ vlo[i]=vtr(vp_+(((i)>>2)*4096+((i)&3)*1024)); vhi[i]=vtr(vp_+(((i)>>2)*4096+((i)&3)*1024+512)); }while(0)
  #define KRD(G,j) do{ if(G){ kload2(kf,kp0+sl_next,j); SBAR(); } }while(0)
  #define STEP(C0,C1,P0,P1,t,GK,GV,GL) do{ SBAR(); CINIT(C0,C1,t); SBAR(); \
    const lds_cptr vp_=vp0+sl_prev; \
    VRD(0); SBAR(); float sacc=(P0[0]+P0[1]); \
    GAPA(C0=__builtin_amdgcn_mfma_f32_32x32x16_bf16(kf[0],qr[0],C0,0,0,0), P0[2],P0[3],P0[4],P0[5],     pw0[0]=PKW(P0,0), pw0[1]=PKW(P0,2), pw0); \
    VRD(4); SBAR(); GAPA(C1=__builtin_amdgcn_mfma_f32_32x32x16_bf16(kf[1],qr[0],C1,0,0,0), P0[6],P0[7],P0[8],P0[9],     pw0[2]=PKW(P0,4), pw0[3]=PKW(P0,6), pw0); \
    VRD(1); SBAR(); GAPA(C0=__builtin_amdgcn_mfma_f32_32x32x16_bf16(kf[2],qr[1],C0,0,0,0),   P0[10],P0[11],P0[12],P0[13], pw1[0]=PKW(P0,8), pw1[1]=PKW(P0,10), pw1); \
    VRD(5); SBAR(); GAPA(C1=__builtin_amdgcn_mfma_f32_32x32x16_bf16(kf[3],qr[1],C1,0,0,0),   P0[14],P0[15],P1[0],P1[1],   pw1[2]=PKW(P0,12),pw1[3]=PKW(P0,14), pw1); \
    VRD(2); SBAR(); GAPA(C0=__builtin_amdgcn_mfma_f32_32x32x16_bf16(kf[4],qr[2],C0,0,0,0),   P1[2],P1[3],P1[4],P1[5],     pw2[0]=PKW(P1,0), pw2[1]=PKW(P1,2), pw2); \
    VRD(6); SBAR(); GAPA(C1=__builtin_amdgcn_mfma_f32_32x32x16_bf16(kf[5],qr[2],C1,0,0,0),   P1[6],P1[7],P1[8],P1[9],     pw2[2]=PKW(P1,4), pw2[3]=PKW(P1,6), pw2); \
    VRD(3); SBAR(); GAPA(C0=__builtin_amdgcn_mfma_f32_32x32x16_bf16(kf[6],qr[3],C0,0,0,0),   P1[10],P1[11],P1[12],P1[13], pw3[0]=PKW(P1,8), pw3[1]=PKW(P1,10), pw3); \
    VRD(7); SBAR(); GAPA(C1=__builtin_amdgcn_mfma_f32_32x32x16_bf16(kf[7],qr[3],C1,0,0,0),   P1[14],P1[15],0.f,0.f,       pw3[2]=PKW(P1,12),pw3[3]=PKW(P1,14), pw3); \
    l_reg+=sacc; \
    if(GK){DMA_K((t)+3,sl_cur);} if(GV){DMA_V((t)+1,sl_next);} \
    CMASK(C0,C1,t); \
    { float a=MX3(C0[0],C0[1],C1[0]),b=MX3(C0[2],C0[3],C1[1]); a=MX3(a,C1[2],C1[3]); \
      _Pragma("unroll") for(int r=4;r<16;r+=4){a=MX3(a,C0[r],C0[r+1]);b=MX3(b,C0[r+2],C0[r+3]);a=MX3(a,C1[r],C1[r+1]);b=MX3(b,C1[r+2],C1[r+3]);} \
      float rm=__builtin_fmaxf(a,b); { auto rr=__builtin_amdgcn_permlane32_swap(__float_as_uint(rm),__float_as_uint(rm),false,false); rm=__builtin_fmaxf(__uint_as_float(rr[0]),__uint_as_float(rr[1])); } \
      resc=false; \
      if(__builtin_expect(__any(rm>(float)THRL),0)){ const float dl=__builtin_fmaxf(rm,0.f); mhat+=dl; \
        _Pragma("unroll") for(int r=0;r<16;++r){C0[r]-=dl;C1[r]-=dl;} \
        const float f=__builtin_amdgcn_exp2f(-dl); l_reg*=f; if(hi==0)wsf[r32]=f; resc=true; } } \
    SBAR(); \
    GAPB(o[0]=__builtin_amdgcn_mfma_f32_32x32x16_bf16(PAF(0),VFR(0),o[0],0,0,0), C0,0); \
    GAPB(o[1]=__builtin_amdgcn_mfma_f32_32x32x16_bf16(PAF(0),VFR(4),o[1],0,0,0), C0,4); \
    KRD(GL,0); GAPB(o[0]=__builtin_amdgcn_mfma_f32_32x32x16_bf16(PAF(1),VFR(1),o[0],0,0,0), C0,8); \
    KRD(GL,1); GAPB(o[1]=__builtin_amdgcn_mfma_f32_32x32x16_bf16(PAF(1),VFR(5),o[1],0,0,0), C0,12); \
    KRD(GL,2); GAPB(o[0]=__builtin_amdgcn_mfma_f32_32x32x16_bf16(PAF(2),VFR(2),o[0],0,0,0), C1,0); \
    KRD(GL,3); GAPB(o[1]=__builtin_amdgcn_mfma_f32_32x32x16_bf16(PAF(2),VFR(6),o[1],0,0,0), C1,4); \
    GAPB(o[0]=__builtin_amdgcn_mfma_f32_32x32x16_bf16(PAF(3),VFR(3),o[0],0,0,0), C1,8); \
    GAPB(o[1]=__builtin_amdgcn_mfma_f32_32x32x16_bf16(PAF(3),VFR(7),o[1],0,0,0), C1,12); \
    }while(0)
  int t=1;
  for(;t+5<NT;t+=2){
    STEP(pB0,pB1,pA0,pA1,t,true,true,true);     WAIT_BAR(2); RESC(); ROT();
    STEP(pA0,pA1,pB0,pB1,t+1,true,true,true);   WAIT_BAR(2); RESC(); ROT();
  }
  #define ENDW(tt) do{ if((tt)+3<NT){WAIT_BAR(2);} else if((tt)+2<NT){WAIT_BAR(1);} else {WAIT_BAR(0);} }while(0)
  for(;t+1<NT;t+=2){
    STEP(pB0,pB1,pA0,pA1,t,(t+3<NT),(t+1<NT),(t+1<NT));       ENDW(t);   RESC(); ROT();
    STEP(pA0,pA1,pB0,pB1,t+1,(t+4<NT),(t+2<NT),(t+2<NT));     ENDW(t+1); RESC(); ROT();
  }
  STEP(pB0,pB1,pA0,pA1,NT-1,false,false,false); RESC();
  { float sacc=pB0[0]+pB0[1]; _Pragma("unroll") for(int r=2;r<16;++r)sacc+=pB0[r]; _Pragma("unroll") for(int r=0;r<16;++r)sacc+=pB1[r]; l_reg+=sacc;
    pw0=(u32x4){PKW(pB0,0),PKW(pB0,2),PKW(pB0,4),PKW(pB0,6)};pw1=(u32x4){PKW(pB0,8),PKW(pB0,10),PKW(pB0,12),PKW(pB0,14)};pw2=(u32x4){PKW(pB1,0),PKW(pB1,2),PKW(pB1,4),PKW(pB1,6)};pw3=(u32x4){PKW(pB1,8),PKW(pB1,10),PKW(pB1,12),PKW(pB1,14)};
    SBAR(); pv(o,vb0+sl_cur,PAF(0),PAF(1),PAF(2),PAF(3)); }
  if(hn){ asm volatile("s_waitcnt lgkmcnt(0)\n\ts_barrier":::"memory");
    const bf16*nK=K+(long)(nb*NHEAD+nh)*(SEQ*D)+wid*512+lane*8,*nV=V+(long)(nb*NHEAD+nh)*(SEQ*D)+wid*512+lane*8; const int nNTF=(nqb*QB+QB)/KVBLK;
    glds16(nK+(long)(nNTF-1)*(KVBLK*D),(unsigned)__builtin_amdgcn_readfirstlane(kdst)); glds16(nV+(long)(nNTF-1)*(KVBLK*D),(unsigned)__builtin_amdgcn_readfirstlane(vdst)); glds16(nK+(long)(nNTF-2)*(KVBLK*D),(unsigned)__builtin_amdgcn_readfirstlane(kdst+SLOTB));
    const bf16*nQ=Q+((long)nb*SEQ+nqb*QB+wid*QBLK)*DM+nh*D;
    #pragma unroll
    for(int d0=0;d0<4;++d0)qn[d0]=*reinterpret_cast<const bf16x8*>(&nQ[(long)r32*DM+d0*16+hi*8]); }
  #undef PKW
  #undef PAF
  #undef VFR
  #undef PIN
  #undef MX3
  #undef GAPA
  #undef GAPB
  #undef EX
  #undef VRD
  #undef KRD
  #undef STEP
  #undef ENDW
  {auto rr=__builtin_amdgcn_permlane32_swap(__float_as_uint(l_reg),__float_as_uint(l_reg),false,false);l_reg=__uint_as_float(rr[0])+__uint_as_float(rr[1]);}
  if(hi==0)wsf[32+r32]=l_reg;asm volatile("s_waitcnt lgkmcnt(0)":::"memory");
  float rli[16];
  #pragma unroll
  for(int r=0;r<16;++r)rli[r]=__builtin_amdgcn_rcpf(wsf[32+crow(r,hi)]);
  bf16*Ow=O+(((rowbase+q0)>>8)*32+h)*16384L; float*sqw=rowsq+(rowbase+q0+wid*QBLK);
  { bf16*stg=(bf16*)(shm+LDS_OST)+wid*2048;
    #pragma unroll
    for(int r=0;r<16;++r){const int orow=crow(r,hi);
      #pragma unroll
      for(int d0=0;d0<2;++d0)stg[orow*64+d0*32+r32]=__float2bfloat16(o[d0][r]*rli[r]);}
    asm volatile("s_waitcnt lgkmcnt(0)":::"memory");
    #pragma unroll
    for(int i=0;i<4;++i){const int row=i*8+(lane>>3),ch=lane&7; const u32x4 v=*(const u32x4*)(stg+row*64+ch*8); ATTN_STORE16(Ow+pg8::img_in(wid*QBLK+row,ch*8),v);
      #define BL(w) __builtin_bit_cast(float,(w)<<16)
      #define BH(w) __builtin_bit_cast(float,(w)&0xffff0000u)
      float ss=(BL(v.x)*BL(v.x)+BH(v.x)*BH(v.x))+(BL(v.y)*BL(v.y)+BH(v.y)*BH(v.y))+(BL(v.z)*BL(v.z)+BH(v.z)*BH(v.z))+(BL(v.w)*BL(v.w)+BH(v.w)*BH(v.w));
      #undef BL
      #undef BH
      ss+=shx<1>(ss); ss+=shx<2>(ss); ss+=shx<4>(ss);
      if(ch==0)__hip_atomic_fetch_add(sqw+row,ss,__ATOMIC_RELAXED,__HIP_MEMORY_SCOPE_AGENT); } }
  asm volatile("s_waitcnt lgkmcnt(0)\n\ts_barrier":::"memory");
  #undef DMA_K
  #undef DMA_V
  #undef CMASK
  #undef CINIT
  #undef START
  #undef RESC
  #undef ROT
}
constexpr int ATTN_LDS_BYTES=LDS_BYTES;
struct AttnTensors { const bf16* Q; const bf16* K; const bf16* V; bf16* O; const float* kmean; float* rowsq; };
struct AttnUnit { int bh; int qb; };
__device__ constexpr unsigned char ATT_TAB[16][8]={{127,101,68,37,26,33,1,0},{119,93,60,36,23,49,7,48},{111,85,52,35,22,41,6,40},{103,77,47,122,90,21,5,32},{95,69,46,114,82,20,4,24},{87,61,45,106,74,19,3,16},{79,53,44,98,66,18,2,8},{71,124,108,91,58,121,25,120},
  {63,116,100,83,50,113,17,112},{126,70,123,75,42,105,15,104},{118,62,115,67,34,97,14,96},{110,55,107,59,31,89,13,88},{102,54,99,51,30,81,12,80},{94,125,92,43,29,73,11,72},{86,117,84,39,28,65,10,64},{78,109,76,38,27,57,9,56}};
struct StaticOrder {
  int vcu,grid;
  __device__ __forceinline__ explicit StaticOrder(int grid_,int vcu_):vcu(vcu_),grid(grid_){}
  __device__ __forceinline__ bool next(int i,AttnUnit&u)const{ const int n=i*grid+vcu; if(n>=BATCH*NHEAD*NQB)return false; const int sid=n%(BATCH*NHEAD),code=ATT_TAB[sid&15][n/(BATCH*NHEAD)]; u.bh=(sid>>4)*NHEAD+(code>>3); u.qb=code&7; return true; }
  __device__ __forceinline__ void a_ready(const AttnUnit&)const{}
  __device__ __forceinline__ void done(const AttnUnit&)const{}
};
template<class Sched,int THRL=8> __device__ __forceinline__ void attn_phase(char*lds,const AttnTensors&T,const Sched&S){
  AttnUnit u,un; bf16x8 qn[4]; qn[0]=qn[1]=qn[2]=qn[3]=bf16x8{}; bool pref=false; bool has=S.next(0,u);
  for(int i=0;has;++i){ const bool hn=S.next(i+1,un); S.a_ready(u);
    attn_unit<THRL>(u.bh/NHEAD,u.bh%NHEAD,u.qb,T.Q,T.K,T.V,T.O,T.kmean,T.rowsq,lds,pref,hn,un.bh/NHEAD,un.bh%NHEAD,un.qb,qn); S.done(u); u=un; has=hn; pref=hn; }
}
#undef SBAR
#undef WAIT_BAR
}
#define GAS __attribute__((address_space(1)))
#define LAS __attribute__((address_space(3)))
typedef unsigned short bf16;
typedef unsigned v4u __attribute__((ext_vector_type(4)));
typedef float f32x4 __attribute__((ext_vector_type(4)));
typedef short bf16x8 __attribute__((ext_vector_type(8)));
typedef GAS unsigned gu32;
typedef GAS unsigned long long gu64;
#define RLX_AGENT __ATOMIC_RELAXED, __HIP_MEMORY_SCOPE_AGENT
#define LDS_WAIT() asm volatile("s_waitcnt lgkmcnt(0)" ::: "memory")
#define VM_WAIT() asm volatile("s_waitcnt vmcnt(0)" ::: "memory")
__device__ __forceinline__ unsigned long long rt() { return __builtin_amdgcn_s_memrealtime(); }
__device__ __forceinline__ unsigned f2bf(float f) { unsigned u = __builtin_bit_cast(unsigned, f); return (u + 0x7fffu + ((u >> 16) & 1u)) >> 16; }
__device__ __forceinline__ unsigned pk2(float lo, float hi) { return f2bf(lo) | (f2bf(hi) << 16); }

#define XB_TMO      128
#define XB_XCNT(j)  (256  + 64 * (j))
#define XB_XSUB(j)  (1280 + 64 * (j))
#define XB_XGEN(j)  (2304 + 64 * (j))
#define XB_TOP      3328
#define XB_TOPGEN   3392
#define XCD_BAR_WORDS 3456
#define XB_SPIN_CAP (1u << 18)

__device__ __forceinline__ unsigned xb_ld(unsigned* p)              { return __hip_atomic_load(p, __ATOMIC_RELAXED, __HIP_MEMORY_SCOPE_AGENT); }
__device__ __forceinline__ unsigned xb_add(unsigned* p, unsigned v) { return __hip_atomic_fetch_add(p, v, __ATOMIC_RELAXED, __HIP_MEMORY_SCOPE_AGENT); }
__device__ __forceinline__ unsigned xb_xcc_id() { return (unsigned)__builtin_amdgcn_s_getreg((3 << 11) | 20) & 0xFu; }
#define XB_SPIN(cond, bar) do { unsigned _sp = 0; while (cond) { __builtin_amdgcn_s_sleep(1); \
    if ((++_sp & 255u) == 0u) { if (xb_ld(&(bar)[XB_TMO])) break; if (_sp > XB_SPIN_CAP) { atomicAdd(&(bar)[XB_TMO], 1u); break; } } } } while (0)

struct XcdBarrier {
    unsigned* bar; unsigned x;
    volatile LAS unsigned* st;
};

__device__ __forceinline__ XcdBarrier xcd_barrier_post(unsigned* bar, volatile LAS unsigned* st) {
    XcdBarrier b; b.bar = bar; b.x = xb_xcc_id(); b.st = st;
    if (threadIdx.x == 0) (void)xb_add(&bar[XB_XCNT(b.x)], 1u);
    return b;
}
__device__ __forceinline__ void xcd_barrier_complete(unsigned* bar, unsigned x, unsigned& nloc, unsigned& nx) {
    const unsigned G = gridDim.x * gridDim.y * gridDim.z;
    unsigned sum, cnt, mine, sp = 0u;
    for (;;) {
        sum = 0u; cnt = 0u; mine = 0u;
#pragma unroll
        for (unsigned j = 0; j < 16; ++j) { const unsigned c = xb_ld(&bar[XB_XCNT(j)]); sum += c; cnt += (c > 0u) ? 1u : 0u; mine = (j == x) ? c : mine; }
        if (sum == G) break;
        __builtin_amdgcn_s_sleep(1);
        if ((++sp & 255u) == 0u) { if (xb_ld(&bar[XB_TMO])) break; if (sp > XB_SPIN_CAP) { atomicAdd(&bar[XB_TMO], 1u); break; } }
    }
    nloc = mine > 0u ? mine : 1u; nx = cnt > 0u ? cnt : 1u;
}

__device__ __forceinline__ void xcd_barrier(const XcdBarrier& b) {
    asm volatile("s_waitcnt vmcnt(0)" ::: "memory");
    __syncthreads();
    if (threadIdx.x == 0) {
        unsigned* bar = b.bar;
        __builtin_amdgcn_s_waitcnt(0);
        unsigned nloc = b.st[0], nx = b.st[1];
        if (nloc == 0u) { xcd_barrier_complete(bar, b.x, nloc, nx); b.st[0] = nloc; b.st[1] = nx; }
        const unsigned old = xb_add(&bar[XB_XSUB(b.x)], 1u);
        const unsigned gen = old / nloc;
        if (old + 1u == (gen + 1u) * nloc) {
            __builtin_amdgcn_fence(__ATOMIC_RELEASE, "agent");
            asm volatile("s_waitcnt vmcnt(0)" ::: "memory");
            const unsigned og = xb_add(&bar[XB_TOP], 1u);
            const unsigned tg = og / nx;
            if (og + 1u == (tg + 1u) * nx) xb_add(&bar[XB_TOPGEN], 1u);
            else XB_SPIN(xb_ld(&bar[XB_TOPGEN]) == tg, bar);
            __builtin_amdgcn_fence(__ATOMIC_ACQUIRE, "agent");
            xb_add(&bar[XB_XGEN(b.x)], 1u);
            asm volatile("s_waitcnt vmcnt(0)" ::: "memory");
        } else {
            XB_SPIN(xb_ld(&bar[XB_XGEN(b.x)]) == gen, bar);
            __builtin_amdgcn_fence(__ATOMIC_ACQUIRE, "agent");
            asm volatile("s_waitcnt vmcnt(0)" ::: "memory");
        }
    }
    __syncthreads();
}

constexpr int NWAVES = 8;
constexpr size_t MiB = 1u << 20;
constexpr size_t WS_CTL = 0, CTL_ZERO_BYTES = 2 * MiB;
constexpr size_t WS_KMEAN = 1 * MiB;
constexpr size_t WS_ROWSQ = 1 * MiB + 512 * 1024;
constexpr size_t WS_WIN = 2 * MiB, WS_WGLU = 19 * MiB, WS_WOUT = 22 * MiB, WS_W1 = 31 * MiB, WS_W2 = 65 * MiB;
constexpr size_t WS_W3 = 98 * MiB, WS_F = 110 * MiB, WS_AT = 118 * MiB;
constexpr size_t WS_X1B = 120 * MiB;
constexpr size_t WS_HID = 256 * MiB;
constexpr size_t WS_XB = 256 * MiB;
constexpr size_t WS_Q = 388 * MiB, WS_K = 452 * MiB, WS_V = 516 * MiB;
constexpr size_t WS_X3 = 580 * MiB;
constexpr size_t WS_L = 676 * MiB;
constexpr size_t WS_ATT = 772 * MiB, WS_ACT = 836 * MiB, WS_SOUT = 904 * MiB, WS_END = 968 * MiB;
static_assert(WS_WIN + (size_t)NPROJ * LDM * 2 <= WS_WGLU && WS_WGLU + (size_t)SW * LDS1 * 2 <= WS_WOUT && WS_WOUT + (size_t)DM * LDM * 2 <= WS_W1 && WS_W1 + (size_t)DFF * LDM * 2 <= WS_W2 && WS_W2 + (size_t)DM * LDF * 2 <= WS_W3, "weight map");
static_assert(WS_X1B + (size_t)MTOK * LDM * 2 <= WS_HID && WS_XB + (size_t)MTOK * LDM * 2 <= WS_Q && WS_L + (size_t)SG * BATCH * NCH * 128 * 4 <= WS_ATT && WS_HID + (size_t)MTOK * LDF * 2 <= WS_ATT && WS_ACT + (size_t)MTOK * LDS1 * 2 <= WS_SOUT, "activation map");
constexpr int CW_TMO = 0, CW_CODE = 1, CW_BAR = 4096, CW_TS = 16384, CW_XQ = 8192;

constexpr int RING_OFF = 0, RING_BYTES = 131072;
constexpr int LDSCTL_OFF = RING_BYTES, MISC_OFF = LDSCTL_OFF + 320;
constexpr int LDS_BYTES = 147456;

struct Args { const float* in[21]; float* out; unsigned char* ws; };
struct Frame {
    LAS unsigned char* lds;
    volatile LAS unsigned* MISC;
    gu32* ctl;
    int tid, lane, wave, vcu, G;
};
__device__ __forceinline__ float wave_sum(float v) {
    v += shx<1>(v); v += shx<2>(v); v += shx<4>(v); v += shx<8>(v); v += shx<16>(v);
    return xsum32(v);
}
__device__ __forceinline__ float bflo(unsigned w) { return __builtin_bit_cast(float, w << 16); }
__device__ __forceinline__ float bfhi(unsigned w) { return __builtin_bit_cast(float, w & 0xffff0000u); }
__device__ __forceinline__ float gelu_tanh(float y) {
    const float z = y * (1.0f + 0.044715f * y * y) * (-2.0f * 0.7978845608028654f * LOG2E);
    return y * __builtin_amdgcn_rcpf(1.0f + __builtin_amdgcn_exp2f(z));
}

__device__ __forceinline__ void ssm_precompute(Frame& F, const Args& A, int g, bf16* W3, bf16* FM, float* AT) {
    LAS float* pwr = (LAS float*)(F.lds + RING_OFF);
    LAS float* pwi = pwr + 17 * 64;
    LAS float* bbr = pwi + 17 * 64;
    LAS float* bbi = bbr + 64 * 16;
    LAS float* ccr = bbi + 64 * 16;
    LAS float* cci = ccr + 16 * 64;
    LAS float* ktab = cci + 16 * 64;
    const int tid = F.tid;
    if (tid < 64) {
        const int p = tid;
        const float dt = expf(A.in[8][g]);
        const float lr = A.in[6][g * SP + p], li = A.in[7][g * SP + p];
        const float mag = expf(lr * dt), a_re = mag * cosf(li * dt), a_im = mag * sinf(li * dt);
        const float den = lr * lr + li * li, nr = a_re - 1.0f;
        const float f_re = (nr * lr + a_im * li) / den, f_im = (a_im * lr - nr * li) / den;
        float pr = 1.0f, pi = 0.0f;
        for (int t = 0; t <= 16; ++t) { pwr[t * 64 + p] = pr; pwi[t * 64 + p] = pi; const float nr2 = pr * a_re - pi * a_im, ni2 = pr * a_im + pi * a_re; pr = nr2; pi = ni2; }
        AT[(g * SP + p) * 2] = pwr[16 * 64 + p]; AT[(g * SP + p) * 2 + 1] = pwi[16 * 64 + p];
        for (int h = 0; h < 16; ++h) { const float br = A.in[9][(size_t)(g * SP + p) * SC + h], bi = A.in[10][(size_t)(g * SP + p) * SC + h];
            bbr[p * 16 + h] = f_re * br - f_im * bi; bbi[p * 16 + h] = f_re * bi + f_im * br; }
    }
    for (int i = tid; i < 16 * 64; i += NWAVES * 64) { ccr[i] = A.in[11][(size_t)g * 16 * 64 + i]; cci[i] = A.in[12][(size_t)g * 16 * 64 + i]; }
    __syncthreads();
    {
        const int h = (tid >> 4) & 15, h2 = tid & 15, t0 = tid >> 8;
        float s[8];
#pragma unroll
        for (int k = 0; k < 8; ++k) s[k] = 0.f;
        for (int p = 0; p < 64; ++p) { const float cr = ccr[h * 64 + p], ci = cci[h * 64 + p], br = bbr[p * 16 + h2], bi = bbi[p * 16 + h2];
            const float U = cr * br - ci * bi, V = cr * bi + ci * br;
#pragma unroll
            for (int k = 0; k < 8; ++k) s[k] += pwr[(2 * k + t0) * 64 + p] * U - pwi[(2 * k + t0) * 64 + p] * V; }
        if (t0 == 0 && h == h2) s[0] += A.in[13][g * SC + h];
#pragma unroll
        for (int k = 0; k < 8; ++k) ktab[(2 * k + t0) * 256 + h * 16 + h2] = s[k];
    }
    __syncthreads();
    bf16* w3 = W3 + (size_t)g * 256 * X3LD;
    for (int idx = tid; idx < 256 * (X3LD / 8); idx += NWAVES * 64) {
        const int row = idx / (X3LD / 8), c8 = (idx % (X3LD / 8)) * 8, i = row >> 4, h = row & 15;
        float v[8];
        if (c8 < 256) { const int j = c8 >> 4, h0 = c8 & 15;
#pragma unroll
            for (int e = 0; e < 8; ++e) v[e] = (j <= i) ? ktab[((i - j) * 16 + h) * 16 + h0 + e] : 0.f;
        } else {
#pragma unroll
            for (int e = 0; e < 8; ++e) { const int ci = c8 - 256 + e, ri = ci >> 6, p = ci & 63; const float ar = pwr[(i + 1) * 64 + p], ai = pwi[(i + 1) * 64 + p], cr = ccr[h * 64 + p], cim = cci[h * 64 + p];
                v[e] = (ri == 0) ? (cr * ar - cim * ai) : -(cr * ai + cim * ar); }
        }
        v4u o; o.x = pk2(v[0], v[1]); o.y = pk2(v[2], v[3]); o.z = pk2(v[4], v[5]); o.w = pk2(v[6], v[7]);
        *(GAS v4u*)(w3 + (size_t)row * X3LD + c8) = o;
    }
    bf16* fm = FM + (size_t)g * 256 * 256;
    for (int idx = tid; idx < 256 * 32; idx += NWAVES * 64) {
        const int row = idx >> 5, c8 = (idx & 31) * 8;
        float v[8];
        if (row < 128) { const int ri = row >> 6, p = row & 63, j = c8 >> 4, h0 = c8 & 15; const float ar = pwr[(15 - j) * 64 + p], ai = pwi[(15 - j) * 64 + p];
#pragma unroll
            for (int e = 0; e < 8; ++e) { const float br = bbr[p * 16 + h0 + e], bi = bbi[p * 16 + h0 + e]; v[e] = (ri == 0) ? (ar * br - ai * bi) : (ar * bi + ai * br); }
        } else {
#pragma unroll
            for (int e = 0; e < 8; ++e) v[e] = 0.f;
        }
        v4u o; o.x = pk2(v[0], v[1]); o.y = pk2(v[2], v[3]); o.z = pk2(v[4], v[5]); o.w = pk2(v[6], v[7]);
        *(GAS v4u*)(fm + (size_t)row * 256 + c8) = o;
    }
    __syncthreads();
}
__device__ __forceinline__ void ssm_carry(Frame& F, const float* L, const float* AT, bf16* X3) {
    if (F.tid >= 256) return;
    for (int gid = F.vcu * 256 + F.tid; gid < SG * BATCH * SP; gid += F.G * 256) {
    const int p = gid & 63, b = (gid >> 6) & 15, g = gid >> 10;
    const float ar = AT[(g * SP + p) * 2], ai = AT[(g * SP + p) * 2 + 1];
    const size_t row0 = (size_t)g * (BATCH * NCH) + (size_t)b * NCH;
    const GAS float* lp = (const GAS float*)L + row0 * (2 * SP) + p;
    GAS bf16* xp = (GAS bf16*)X3 + row0 * X3LD + 256 + p;
    float sr = 0.f, si = 0.f;
    for (int c0 = 0; c0 < NCH; c0 += 16) {
        float lr[16], li[16];
#pragma unroll
        for (int k = 0; k < 16; ++k) { lr[k] = lp[(size_t)(c0 + k) * (2 * SP)]; li[k] = lp[(size_t)(c0 + k) * (2 * SP) + SP]; }
#pragma unroll
        for (int k = 0; k < 16; ++k) { xp[(size_t)(c0 + k) * X3LD] = (bf16)f2bf(sr); xp[(size_t)(c0 + k) * X3LD + SP] = (bf16)f2bf(si);
            const float nr = ar * sr - ai * si + lr[k], ni = ar * si + ai * sr + li[k]; sr = nr; si = ni; }
    }
    }
}

template <int GAIN, int PERMQ, bool BLK = false>
__device__ __forceinline__ void p0_transpose_item(const float* W, const float* gk, const float* gk2, int ksplit, int K, int N, bf16* WT, int ldt, LAS float* scr, int item, int lane) {
    const int nblk = N / 32, kb = item / nblk, nb = item % nblk, k0 = 64 * kb, n0 = 32 * nb;
#pragma unroll 8
    for (int i = 0; i < 32; ++i) { const int kk = 2 * i + (lane >> 5), k = k0 + kk; float w = W[(size_t)k * N + n0 + (lane & 31)];
        if constexpr (GAIN == 1) w *= gk[k];
        if constexpr (GAIN == 2) { const float* gp = (k < ksplit) ? gk + k : gk2 + (k - ksplit); w *= *gp; }
        scr[kk * 33 + (lane & 31)] = w; }
    LDS_WAIT(); asm volatile("" ::: "memory");
    int d0 = n0;
    if (PERMQ == 2 || (PERMQ == 1 && nb < 64)) { const int w8 = nb & 7; d0 = (nb & ~7) * 32 + 32 * (4 * (w8 & 1) + (w8 >> 1)); }
    const int c = lane & 7;
#pragma unroll
    for (int j = 0; j < 4; ++j) { const int n = (lane >> 3) + 8 * j; const LAS float* s = scr + (8 * c) * 33 + n;
        v4u o; o.x = pk2(s[0 * 33], s[1 * 33]); o.y = pk2(s[2 * 33], s[3 * 33]); o.z = pk2(s[4 * 33], s[5 * 33]); o.w = pk2(s[6 * 33], s[7 * 33]);
        if constexpr (BLK) { const int P = d0 + n; *(GAS v4u*)(WT + ((size_t)(P >> 8) * (K / 64) + kb) * 16384 + pg8::img_in((P & 255 & ~31) + pg8::inv_perm32(P & 31), 8 * c)) = o; }
        else *(GAS v4u*)(WT + (size_t)(d0 + n) * ldt + k0 + 8 * c) = o; }
    LDS_WAIT(); asm volatile("" ::: "memory");
}
__device__ __forceinline__ void rms_row_to_bf16(const float* xrow, bf16* orow, int rit, int lane) {
    const GAS f32x4* xr = (const GAS f32x4*)xrow + lane;
    f32x4 v[8]; float s = 0.f;
#pragma unroll
    for (int j = 0; j < 8; ++j) { v[j] = xr[64 * j]; s += (v[j].x * v[j].x + v[j].y * v[j].y) + (v[j].z * v[j].z + v[j].w * v[j].w); }
    const float r = rsqrtf(wave_sum(s) * (1.0f / (float)DM) + EPS);
    GAS bf16* ob = (GAS bf16*)orow + (size_t)(lane >> 4) * 16384 + pg8::img_in(rit, 4 * (lane & 15));
#pragma unroll
    for (int j = 0; j < 8; ++j) *(GAS unsigned long long*)(ob + (size_t)j * 4 * 16384) = (unsigned long long)pk2(v[j].x * r, v[j].y * r) | ((unsigned long long)pk2(v[j].z * r, v[j].w * r) << 32);
}
__device__ __forceinline__ void p0_prologue(Frame& F, const Args& A) {
    unsigned char* ws = A.ws;
    LAS float* scr = (LAS float*)(F.lds + RING_OFF + F.wave * 16384);
    const int gw = F.vcu * NWAVES + F.wave, NGW = F.G * NWAVES;
    for (int g = F.vcu; g < SG; g += F.G) ssm_precompute(F, A, g, (bf16*)(ws + WS_W3), (bf16*)(ws + WS_F), (float*)(ws + WS_AT));
    constexpr int I_IN = (DM / 64) * (NPROJ / 32), I_GLU = (SW / 64) * (SW / 32), I_OUT = (DM / 64) * (DM / 32), I_1 = (DM / 64) * (DFF / 32), I_2 = (DFF / 64) * (DM / 32);
    constexpr int NITEMS = I_IN + I_GLU + I_OUT + I_1 + I_2;
    for (int it = gw; it < NITEMS; it += NGW) {
        int r = it;
        if (r < I_IN) { p0_transpose_item<1, 1, true>(A.in[2], A.in[1], A.in[1], DM, DM, NPROJ, (bf16*)(ws + WS_WIN), 64, scr, r, F.lane); continue; } r -= I_IN;
        if (r < I_GLU) { p0_transpose_item<0, 0, 1>(A.in[14], A.in[14], A.in[14], SW, SW, SW, (bf16*)(ws + WS_WGLU), 64, scr, r, F.lane); continue; } r -= I_GLU;
        if (r < I_OUT) { p0_transpose_item<2, 0, true>(A.in[17], A.in[5], A.in[16], AW, DM, DM, (bf16*)(ws + WS_WOUT), 64, scr, r, F.lane); continue; } r -= I_OUT;
        if (r < I_1) { p0_transpose_item<1, 2, true>(A.in[19], A.in[18], A.in[18], DM, DM, DFF, (bf16*)(ws + WS_W1), 64, scr, r, F.lane); continue; } r -= I_1;
        p0_transpose_item<0, 0, true>(A.in[20], A.in[20], A.in[20], DFF, DFF, DM, (bf16*)(ws + WS_W2), 64, scr, r, F.lane);
    }
    __syncthreads();
    {   int it2 = 0; const int lane = F.lane;
        f32x4 v[2][8];
#define P0_LOADX(g_) do { _Pragma("unroll") for (int rr2 = 0; rr2 < 2; ++rr2) { const GAS f32x4* xr = (const GAS f32x4*)(A.in[0] + (size_t)((g_) * 16 + 2 * F.wave + rr2) * DM) + lane; \
            _Pragma("unroll") for (int j = 0; j < 8; ++j) v[rr2][j] = xr[64 * j]; } } while (0)
        if (F.vcu < MTOK / 16) P0_LOADX(F.vcu);
        for (int grp = F.vcu; grp < MTOK / 16; ++it2) {
            LAS unsigned char* buf = F.lds + RING_OFF + (it2 & 1) * 65536;
            if (F.tid == 0) F.MISC[16 + (it2 & 1)] = (unsigned)F.G + __hip_atomic_fetch_add(F.ctl + CW_XQ, 1u, RLX_AGENT);
#pragma unroll
            for (int rr2 = 0; rr2 < 2; ++rr2) {
                const int r = 2 * F.wave + rr2;
                float sq = 0.f;
#pragma unroll
                for (int j = 0; j < 8; ++j) sq += (v[rr2][j].x * v[rr2][j].x + v[rr2][j].y * v[rr2][j].y) + (v[rr2][j].z * v[rr2][j].z + v[rr2][j].w * v[rr2][j].w);
                const float rn = rsqrtf(wave_sum(sq) * (1.0f / (float)DM) + EPS);
                const int c = 4 * (lane & 15), inoff = (c >> 5) * 1024 + ((r * 64 + (c & 31) * 2) ^ (((r >> 3) & 1) << 5));
#pragma unroll
                for (int j = 0; j < 8; ++j) *(LAS unsigned long long*)(buf + (4 * j + (lane >> 4)) * 2048 + inoff) = (unsigned long long)pk2(v[rr2][j].x * rn, v[rr2][j].y * rn) | ((unsigned long long)pk2(v[rr2][j].z * rn, v[rr2][j].w * rn) << 32);
            }
            LDS_WAIT(); __syncthreads();
            const int nxt = (int)F.MISC[16 + (it2 & 1)];
            if (nxt < MTOK / 16) P0_LOADX(nxt);
            {   const int q = grp & 15;
                GAS unsigned char* dst = (GAS unsigned char*)(ws + WS_XB) + (size_t)(grp >> 4) * (DM / 64) * 32768 + (q >> 3) * 16384 + (q & 7) * 2048;
#pragma unroll
                for (int k = 0; k < 8; ++k) { const int sub = F.wave + 8 * k, kt = sub >> 1, cs = sub & 1;
                    const v4u w = *(const LAS v4u*)(buf + sub * 1024 + lane * 16);
                    *(GAS v4u*)(dst + (size_t)kt * 32768 + cs * 1024 + lane * 16) = w; }
            }
            grp = nxt;
        }
#undef P0_LOADX
        __syncthreads();
    }
}

__global__ void __launch_bounds__(NWAVES * 64, 2) hymba_fwd(Args args) {
    extern __shared__ __attribute__((aligned(16))) unsigned char lds[];
    Frame F;
    F.lds = (LAS unsigned char*)lds;
    F.MISC = (volatile LAS unsigned*)(F.lds + MISC_OFF);
    F.tid = threadIdx.x; F.lane = F.tid & 63; F.wave = __builtin_amdgcn_readfirstlane(F.tid >> 6);
    F.G = gridDim.x; { const int bx = blockIdx.x; F.vcu = (F.G % 8 == 0) ? (bx % 8) * (F.G / 8) + bx / 8 : bx; }
    unsigned char* ws = args.ws;
    F.ctl = (gu32*)(ws + WS_CTL);
    for (int u = F.tid; u < (LDS_BYTES - LDSCTL_OFF) / 4; u += NWAVES * 64) ((LAS unsigned*)(F.lds + LDSCTL_OFF))[u] = 0u;
    __syncthreads();
    XcdBarrier bar = xcd_barrier_post((unsigned*)(F.ctl + CW_BAR), F.MISC + 8);
#define GRID_BAR(k) xcd_barrier(bar)

    bf16* const XB = (bf16*)(ws + WS_XB); bf16* const QB = (bf16*)(ws + WS_Q); bf16* const KB = (bf16*)(ws + WS_K); bf16* const VB = (bf16*)(ws + WS_V);
    bf16* const X3 = (bf16*)(ws + WS_X3); bf16* const ATT = (bf16*)(ws + WS_ATT); bf16* const ACT = (bf16*)(ws + WS_ACT); bf16* const SOUT = (bf16*)(ws + WS_SOUT);
    bf16* const X1B = (bf16*)(ws + WS_X1B); bf16* const HID = (bf16*)(ws + WS_HID);
    float* const LBUF = (float*)(ws + WS_L);
    float* const KMEAN = (float*)(ws + WS_KMEAN); float* const ROWSQ = (float*)(ws + WS_ROWSQ); float* const ROWSQA = ROWSQ + MTOK; float* const ROWSQS = ROWSQ + 2 * MTOK;

    p0_prologue(F, args);
    GRID_BAR(0);
    {   pg8::Gemm g{XB, (const bf16*)(ws + WS_WIN), MTOK, NPROJ, DM, 64, 64, true, true}; pg8::StaticOrder S; S.init(MTOK, NPROJ, F.G, (int)blockIdx.x);
        pg8::EpiProj E{QB, KB, VB, X3, KMEAN, args.in[3], args.in[4]};
        pg8::gemm_phase<pg8::EpiProj, pg8::StaticOrder, true, true>(F.lds + RING_OFF, g, S, E); }
    GRID_BAR(1);
    {   pg8::Gemm g{X3, (const bf16*)(ws + WS_F), SG * BATCH * NCH, 256, SCH * SC, X3LD, SCH * SC}; pg8::GroupOrder S{(int)F.G, F.vcu};
        pg8::EpiSsmL E{LBUF};
        pg8::gemm_phase<pg8::EpiSsmL, pg8::GroupOrder, true, true>(F.lds + RING_OFF, g, S, E); }
    GRID_BAR(2);
    ssm_carry(F, LBUF, (const float*)(ws + WS_AT), X3);
    {   const attn_body::AttnTensors AT{(const attn_body::bf16*)QB, (const attn_body::bf16*)KB, (const attn_body::bf16*)VB, (attn_body::bf16*)XB, KMEAN, ROWSQA};
        const attn_body::StaticOrder S((int)F.G, F.vcu);
        attn_body::attn_phase<attn_body::StaticOrder>((char*)lds + RING_OFF, AT, S); }
    GRID_BAR(3);
    {   pg8::Gemm g{X3, (const bf16*)(ws + WS_W3), SG * BATCH * NCH, 256, X3LD, X3LD, X3LD}; pg8::GroupOrder S{(int)F.G, F.vcu};
        pg8::EpiSsmY E{ACT};
        pg8::gemm_phase<pg8::EpiSsmY, pg8::GroupOrder, true, true>(F.lds + RING_OFF, g, S, E); }
    GRID_BAR(4);
    {   pg8::Gemm g{ACT, (const bf16*)(ws + WS_WGLU), MTOK, SW, SW, 64, 64, true, true}; pg8::StaticOrder S; S.init(MTOK, SW, F.G, (int)blockIdx.x);
        pg8::EpiGlu E{ACT, XB, args.in[15], ROWSQS};
        pg8::gemm_phase<pg8::EpiGlu, pg8::StaticOrder, true, true>(F.lds + RING_OFF, g, S, E); }
    GRID_BAR(5);
    {   pg8::Gemm g{XB, (const bf16*)(ws + WS_WOUT), MTOK, DM, DM, 64, 64, true, true}; pg8::StaticOrder S; S.init(MTOK, DM, F.G, (int)blockIdx.x);
        pg8::EpiWout E{args.in[0], X1B, ROWSQ, ROWSQA, ROWSQS};
        pg8::gemm_phase<pg8::EpiWout, pg8::StaticOrder, true, true>(F.lds + RING_OFF, g, S, E); }
    GRID_BAR(6);
    {   pg8::Gemm g{X1B, (const bf16*)(ws + WS_W1), MTOK, DFF, DM, 64, 64, true, true}; pg8::StaticOrder S; S.init(MTOK, DFF, F.G, (int)blockIdx.x);
        pg8::EpiFF1 E{HID, ROWSQ};
        pg8::gemm_phase<pg8::EpiFF1, pg8::StaticOrder, true, true>(F.lds + RING_OFF, g, S, E); }
    GRID_BAR(7);
    {   pg8::Gemm g{HID, (const bf16*)(ws + WS_W2), MTOK, DM, DFF, 64, 64, true, true}; pg8::StaticOrder S; S.init(MTOK, DM, F.G, (int)blockIdx.x, 4);
        pg8::EpiFF2 E{args.out, X1B};
        pg8::gemm_phase<pg8::EpiFF2, pg8::StaticOrder, true, true>(F.lds + RING_OFF, g, S, E); }
#undef GRID_BAR
}

extern "C" void kernel_launch(void* const* d_in, const int* in_sizes, int n_in, void* d_out, int out_size, void* d_ws, size_t ws_size, hipStream_t stream) {
    static int grid = 0;
    if (grid == 0) {
        if (n_in != 21 || in_sizes[0] != MTOK * DM || out_size != MTOK * DM || ws_size < WS_END) { fprintf(stderr, "kernel_launch: unexpected shapes (n_in %d, in0 %d, out %d, ws %zu); nothing launched\n", n_in, n_in > 0 ? in_sizes[0] : -1, out_size, ws_size); grid = -1; return; }
        int dev = 0, cus = 0, per_cu = 0;
        if (hipGetDevice(&dev) != hipSuccess || hipDeviceGetAttribute(&cus, hipDeviceAttributeMultiprocessorCount, dev) != hipSuccess) { grid = -1; return; }
        if (hipFuncSetAttribute((const void*)hymba_fwd, hipFuncAttributeMaxDynamicSharedMemorySize, LDS_BYTES) != hipSuccess) { fprintf(stderr, "kernel_launch: hipFuncSetAttribute failed\n"); grid = -1; return; }
        if (hipOccupancyMaxActiveBlocksPerMultiprocessor(&per_cu, (const void*)hymba_fwd, NWAVES * 64, LDS_BYTES) != hipSuccess || per_cu < 1) { fprintf(stderr, "kernel_launch: occupancy query reports %d workgroups per CU\n", per_cu); (void)hipGetLastError(); grid = -1; return; }
        grid = cus;
    }
    if (grid < 0) return;
    if (hipMemsetAsync((char*)d_ws + WS_CTL, 0, CTL_ZERO_BYTES, stream) != hipSuccess) return;
    Args a{};
    for (int i = 0; i < 21; ++i) a.in[i] = (const float*)d_in[i];
    a.out = (float*)d_out; a.ws = (unsigned char*)d_ws;
    hipLaunchKernelGGL(hymba_fwd, dim3(grid), dim3(NWAVES * 64), LDS_BYTES, stream, a);
}
```

```cpp
#include <hip/hip_runtime.h>
#include <cstdio>
#include <cstdint>

constexpr int BATCH = 16, SEQ = 2048, DM = 2048, MTOK = BATCH * SEQ;
constexpr int AW = 1024, SW = 1024, NPROJ = 4096, NH = 16, HD = 64, DFF = 8192, NBLK = 8, MOBA = 256;
constexpr int SG = 64, SC = 16, SP = 64;
constexpr int SCH = 16, NCH = SEQ / SCH;
constexpr int X3LD = SCH * SC + 2 * SP;
constexpr int LDM = DM + 64, LDF = DFF + 64, LDS1 = SW + 64;
constexpr float EPS = 1e-6f;
constexpr float LOG2E = 1.4426950408889634f;
constexpr float QSCALE = 0.125f * LOG2E;

template <int MASK> __device__ __forceinline__ float shx(float v) { static_assert(MASK >= 1 && MASK <= 16, "shx"); return __builtin_bit_cast(float, __builtin_amdgcn_ds_swizzle(__builtin_bit_cast(int, v), (MASK << 10) | 0x1f)); }
__device__ __forceinline__ float xsum32(float v) { auto rr = __builtin_amdgcn_permlane32_swap(__float_as_uint(v), __float_as_uint(v), false, false); unsigned a = rr[0], b = rr[1]; asm volatile("" : "+v"(a), "+v"(b)); return __uint_as_float(a) + __uint_as_float(b); }
namespace pg8 {
#define PG8_LAS __attribute__((address_space(3)))
typedef unsigned short bf16_t;
typedef short bf16x8 __attribute__((ext_vector_type(8)));
typedef float f32x4 __attribute__((ext_vector_type(4)));
typedef unsigned u32x4 __attribute__((ext_vector_type(4)));
constexpr int BM = 256, BK = 64, HALF = 128, HTB = HALF * BK * 2  , STAGE_BYTES = 8 * HTB, NXCD = 8, WGM = 8;

__host__ __device__ __forceinline__ int lds_byte(int r, int c) { const int st = (r >> 4) * 2 + (c >> 5), rr = r & 15, cc = c & 31, ob = rr * 64 + cc * 2; return st * 1024 + (ob ^ (((ob >> 9) & 1) << 5)); }
__host__ __device__ __forceinline__ void stage_rc(int b, int& R, int& C) { const int st = b / 1024, sb = b % 1024, swz = sb ^ (((sb >> 9) & 1) << 5); R = (st >> 1) * 16 + swz / 64; C = (st & 1) * 32 + (swz % 64) / 2; }
__host__ __device__ __forceinline__ int perm32(int rho) { const int n = rho >> 4, i = rho & 15; return 8 * (i >> 2) + 4 * n + (i & 3); }

__host__ __device__ __forceinline__ int img_in(int r, int c) { return (r >> 7) * (HTB / 2) + lds_byte(r & 127, c) / 2; }
__host__ __device__ __forceinline__ int inv_perm32(int w) { return 16 * ((w >> 2) & 1) + 4 * (w >> 3) + (w & 3); }
struct Unit { int pm, pn; };
struct Gemm { const bf16_t* A; const bf16_t* Bt; int M, N, K, lda, ldb; bool blkA = false, blkB = false; };

struct StaticOrder {
    int nM, nN, nwg, G, c, wgm;
    __host__ __device__ void init(int M, int N, int G_, int c_, int wgm_ = WGM) { nM = M / BM; nN = N / BM; nwg = nM * nN; G = G_; c = c_; wgm = wgm_; }
    __host__ __device__ bool next(int i, Unit& u) const {
        const long L = (long)i * G + c; if (L >= nwg) return false;
        int wgid = (int)L; { const int q = nwg / NXCD, r = nwg % NXCD, xcd = wgid % NXCD, off = wgid / NXCD; wgid = (xcd < r ? xcd * (q + 1) : r * (q + 1) + (xcd - r) * q) + off; }
        const int nig = wgm * nN, gid = wgid / nig, fm = gid * wgm, gsz = (nM - fm) < wgm ? (nM - fm) : wgm;
        u.pm = fm + ((wgid % nig) % gsz); u.pn = (wgid % nig) / gsz; return true;
    }
    __device__ __forceinline__ void a_ready(const Unit&) const {}
    __device__ __forceinline__ void done(const Unit&) const {}
};

__device__ __forceinline__ unsigned cvt_pk_bf16(float lo, float hi) { unsigned r; asm volatile("v_cvt_pk_bf16_f32 %0, %1, %2" : "=v"(r) : "v"(lo), "v"(hi)); return r; }
typedef float f32x2 __attribute__((ext_vector_type(2)));
template <class Epi, class Sched, bool ALIGN_EPI = false, bool SP2 = false>
__device__ __forceinline__ void gemm_phase(PG8_LAS unsigned char* lds, const Gemm g, const Sched& S, const Epi& E) {
    int tid_ = threadIdx.x; asm volatile("" : "+v"(tid_));
    const int tid = tid_, wid = __builtin_amdgcn_readfirstlane(tid >> 6), lane = tid & 63, wr = wid >> 2, wc = wid & 3, fr = lane & 15, fq = lane >> 4;
    const int K = g.K, nt = K / BK;
    unsigned voffA[2], voffB[2];
#pragma unroll
    for (int i = 0; i < 2; ++i) { int R, C; stage_rc(tid * 16 + i * 8192, R, C); const int Rb = Epi::PERM ? ((R & ~31) + perm32(R & 31)) : R;
        voffA[i] = g.blkA ? (unsigned)(tid * 16 + i * 8192) : (unsigned)(R * g.lda + C) * 2u; voffB[i] = g.blkB ? (unsigned)(tid * 16 + i * 8192) : (unsigned)(Rb * g.ldb + C) * 2u; }
    const size_t kstepA = g.blkA ? (size_t)(BM * BK * 2) : (size_t)(BK * 2), kstepB = g.blkB ? (size_t)(BM * BK * 2) : (size_t)(BK * 2);
    const size_t hstepA = (size_t)HALF * g.lda * 2, hstepB = (size_t)HALF * g.ldb * 2;
    const size_t tstepA = g.blkA ? (size_t)nt * (BM * BK * 2) : 2 * hstepA, tstepB = g.blkB ? (size_t)nt * (BM * BK * 2) : 2 * hstepB;
    const unsigned ldsw = (unsigned)wid * 1024u;
    const int aoff = lds_byte(wr * 64 + fr, fq * 8), boff = lds_byte(wc * 32 + fr, fq * 8);
#define PG8_SA(b, h) (((b) * 2 + (h)) * HTB)
#define PG8_SB(b, h) ((4 + (b) * 2 + (h)) * HTB)
#define PG8_STAGE(bufoff, gbase, voff) do { _Pragma("unroll") for (int _i = 0; _i < 2; ++_i) \
        __builtin_amdgcn_global_load_lds((const unsigned*)((const char*)(gbase) + (voff)[_i]), (PG8_LAS unsigned*)(lds + (bufoff) + ldsw + _i * 8192), 16, 0, 0); } while (0)
#define PG8_LDA(dst, b, h) do { _Pragma("unroll") for (int m = 0; m < 4; ++m) _Pragma("unroll") for (int k = 0; k < 2; ++k) dst[m][k] = *(const PG8_LAS bf16x8*)(lds + PG8_SA(b, h) + aoff + m * 2048 + k * 1024); } while (0)
#define PG8_LDB(dst, b, h) do { _Pragma("unroll") for (int n = 0; n < 2; ++n) _Pragma("unroll") for (int k = 0; k < 2; ++k) dst[n][k] = *(const PG8_LAS bf16x8*)(lds + PG8_SB(b, h) + boff + n * 2048 + k * 1024); } while (0)
#define PG8_MMA(ai, bj, At, Bt) do { __builtin_amdgcn_s_setprio(1); _Pragma("unroll") for (int m = 0; m < 4; ++m) _Pragma("unroll") for (int n = 0; n < 2; ++n) _Pragma("unroll") for (int k = 0; k < 2; ++k) \
        acc[ai][bj][m][n] = __builtin_amdgcn_mfma_f32_16x16x32_bf16(Bt[n][k], At[m][k], acc[ai][bj][m][n], 0, 0, 0); __builtin_amdgcn_s_setprio(0); } while (0)
#define PG8_WAIT_V(n) asm volatile("s_waitcnt vmcnt(" #n ")" ::: "memory")
#define PG8_WAIT_L(n) asm volatile("s_waitcnt lgkmcnt(" #n ")" ::: "memory")
#define PG8_BAR __builtin_amdgcn_s_barrier()
#define PG8_SCHED __builtin_amdgcn_sched_barrier(0)
    Unit cur, nxt; int ui = 0;
    if (!S.next(0, cur)) return;
    f32x4 acc[2][2][4][2];
#pragma unroll
    for (int a = 0; a < 2; ++a)
#pragma unroll
        for (int b = 0; b < 2; ++b)
#pragma unroll
            for (int m = 0; m < 4; ++m)
#pragma unroll
                for (int n = 0; n < 2; ++n) acc[a][b][m][n] = (f32x4){0.f, 0.f, 0.f, 0.f};
    bf16x8 At[4][2], B0[2][2], B1[2][2];
    const char* cA = (const char*)g.A + (size_t)cur.pm * tstepA; const char* cB = (const char*)g.Bt + (size_t)cur.pn * tstepB;
    S.a_ready(cur);
    if constexpr (SP2) {
        PG8_STAGE(PG8_SB(0, 0), cB, voffB); PG8_STAGE(PG8_SB(0, 1), cB + hstepB, voffB); PG8_STAGE(PG8_SA(0, 0), cA, voffA); PG8_STAGE(PG8_SA(0, 1), cA + hstepA, voffA);
        if (wr == 1) PG8_BAR;
        PG8_WAIT_V(2); PG8_BAR;
        PG8_STAGE(PG8_SB(1, 0), cB + kstepB, voffB); PG8_STAGE(PG8_SA(1, 0), cA + kstepA, voffA); PG8_STAGE(PG8_SB(1, 1), cB + hstepB + kstepB, voffB);
        PG8_WAIT_V(6); PG8_BAR;
    } else {
        PG8_STAGE(PG8_SB(0, 0), cB, voffB); PG8_STAGE(PG8_SA(0, 0), cA, voffA); PG8_STAGE(PG8_SB(0, 1), cB + hstepB, voffB); PG8_STAGE(PG8_SA(0, 1), cA + hstepA, voffA);
        if (wr == 1) PG8_BAR;
        PG8_WAIT_V(4); PG8_BAR;
        PG8_STAGE(PG8_SB(1, 0), cB + kstepB, voffB); PG8_STAGE(PG8_SA(1, 0), cA + kstepA, voffA); PG8_STAGE(PG8_SB(1, 1), cB + hstepB + kstepB, voffB);
        PG8_WAIT_V(6); PG8_BAR;
    }
    for (;;) {
        const bool has_next = S.next(ui + 1, nxt);
        const char* nA = has_next ? (const char*)g.A + (size_t)nxt.pm * tstepA : cA; const char* nB = has_next ? (const char*)g.Bt + (size_t)nxt.pn * tstepB : cB;
        for (int t = 0; t < nt; t += 2) {
            if constexpr (Epi::MIDK) { if (t == nt / 2) E.mid(acc, cur, wr, wc, fr, fq); }
            const bool last = (t == nt - 2);
            const char* a1 = cA + (size_t)(t + 1) * kstepA;
            const char* a2 = last ? nA : cA + (size_t)(t + 2) * kstepA; const char* b2 = last ? nB : cB + (size_t)(t + 2) * kstepB;
            const char* a3 = a2 + kstepA; const char* b3 = b2 + kstepB;
            if (last && has_next) S.a_ready(nxt);
            if constexpr (SP2) {
            PG8_LDB(B0, 0, 0); PG8_LDB(B1, 0, 1); PG8_SCHED; PG8_LDA(At, 0, 0); PG8_STAGE(PG8_SA(1, 1), a1 + hstepA, voffA);
            PG8_WAIT_V(8); PG8_WAIT_L(0); PG8_BAR; PG8_MMA(0, 0, At, B0); PG8_MMA(0, 1, At, B1); PG8_BAR; PG8_SCHED;
            PG8_LDA(At, 0, 1); PG8_STAGE(PG8_SB(0, 0), b2, voffB); PG8_STAGE(PG8_SB(0, 1), b2 + hstepB, voffB); PG8_STAGE(PG8_SA(0, 0), a2, voffA);
            PG8_WAIT_V(8); PG8_WAIT_L(0); PG8_BAR; PG8_MMA(1, 0, At, B0); PG8_MMA(1, 1, At, B1); PG8_BAR; PG8_SCHED;
            PG8_LDB(B0, 1, 0); PG8_LDB(B1, 1, 1); PG8_SCHED; PG8_LDA(At, 1, 0); PG8_STAGE(PG8_SA(0, 1), a2 + hstepA, voffA);
            PG8_WAIT_V(8); PG8_WAIT_L(0); PG8_BAR; PG8_MMA(0, 0, At, B0); PG8_MMA(0, 1, At, B1); PG8_BAR; PG8_SCHED;
            PG8_LDA(At, 1, 1); PG8_STAGE(PG8_SB(1, 0), b3, voffB); PG8_STAGE(PG8_SB(1, 1), b3 + hstepB, voffB); PG8_STAGE(PG8_SA(1, 0), a3, voffA);
            PG8_WAIT_V(8); PG8_WAIT_L(0); PG8_BAR; PG8_MMA(1, 0, At, B0); PG8_MMA(1, 1, At, B1); PG8_BAR; PG8_SCHED;
            } else {
            PG8_LDB(B0, 0, 0); PG8_SCHED; PG8_LDA(At, 0, 0); PG8_STAGE(PG8_SA(1, 1), a1 + hstepA, voffA);
            PG8_WAIT_L(8); PG8_BAR; PG8_WAIT_L(0); PG8_MMA(0, 0, At, B0); PG8_BAR; PG8_SCHED;
            PG8_LDB(B1, 0, 1); PG8_STAGE(PG8_SB(0, 0), b2, voffB);
            PG8_BAR; PG8_WAIT_L(0); PG8_MMA(0, 1, At, B1); PG8_BAR;
            PG8_LDA(At, 0, 1); PG8_STAGE(PG8_SA(0, 0), a2, voffA);
            PG8_BAR; PG8_WAIT_L(0); PG8_MMA(1, 0, At, B0); PG8_BAR; PG8_SCHED;
            PG8_STAGE(PG8_SB(0, 1), b2 + hstepB, voffB);
            PG8_WAIT_V(6); PG8_BAR; PG8_MMA(1, 1, At, B1); PG8_BAR;
            PG8_LDB(B0, 1, 0); PG8_SCHED; PG8_LDA(At, 1, 0); PG8_STAGE(PG8_SA(0, 1), a2 + hstepA, voffA);
            PG8_WAIT_L(8); PG8_BAR; PG8_WAIT_L(0); PG8_MMA(0, 0, At, B0); PG8_BAR; PG8_SCHED;
            PG8_LDB(B1, 1, 1); PG8_STAGE(PG8_SB(1, 0), b3, voffB);
            PG8_BAR; PG8_WAIT_L(0); PG8_MMA(0, 1, At, B1); PG8_BAR;
            PG8_LDA(At, 1, 1); PG8_STAGE(PG8_SA(1, 0), a3, voffA);
            PG8_BAR; PG8_WAIT_L(0); PG8_MMA(1, 0, At, B0); PG8_BAR; PG8_SCHED;
            PG8_STAGE(PG8_SB(1, 1), b3 + hstepB, voffB);
            PG8_WAIT_V(6); PG8_BAR; PG8_MMA(1, 1, At, B1); PG8_BAR;
            }
        }
        if constexpr (ALIGN_EPI) { if (wr == 0) PG8_BAR; }
        if constexpr (!Epi::AFTER_DRAIN) { E(acc, cur, wr, wc, fr, fq); S.done(cur); }
        if (!has_next) break;
#pragma unroll
        for (int a = 0; a < 2; ++a)
#pragma unroll
            for (int b = 0; b < 2; ++b)
#pragma unroll
                for (int m = 0; m < 4; ++m)
#pragma unroll
                    for (int n = 0; n < 2; ++n) acc[a][b][m][n] = (f32x4){0.f, 0.f, 0.f, 0.f};
        cur = nxt; cA = nA; cB = nB; ++ui;
        if constexpr (ALIGN_EPI) { if (wr == 1) PG8_BAR; }
    }
    PG8_WAIT_V(0);
    if constexpr (!ALIGN_EPI) { if (wr == 0) PG8_BAR; }
    PG8_BAR;
    if constexpr (Epi::AFTER_DRAIN) { E.fused(acc, cur, wr, wc, fr, fq, lds, wid, lane); S.done(cur); }
#undef PG8_SA
#undef PG8_SB
#undef PG8_STAGE
#undef PG8_LDA
#undef PG8_LDB
#undef PG8_MMA
#undef PG8_WAIT_V
#undef PG8_WAIT_L
#undef PG8_BAR
#undef PG8_SCHED
}
__device__ __forceinline__ u32x4 pack8(const f32x4 v0, const f32x4 v1) { u32x4 w; w.x = cvt_pk_bf16(v0[0], v0[1]); w.y = cvt_pk_bf16(v0[2], v0[3]); w.z = cvt_pk_bf16(v1[0], v1[1]); w.w = cvt_pk_bf16(v1[2], v1[3]); return w; }
__device__ __forceinline__ float bflo(unsigned w) { return __builtin_bit_cast(float, w << 16); }
__device__ __forceinline__ float bfhi(unsigned w) { return __builtin_bit_cast(float, w & 0xffff0000u); }
__device__ __forceinline__ size_t blk_off(int pm, int nkt, int kt, int r, int c) { return ((size_t)pm * nkt + kt) * (BM * BK) + img_in(r, c); }
__device__ __forceinline__ float relu1(float x) { float r; asm("v_max_f32_e32 %0, 0, %1" : "=v"(r) : "v"(x)); return r; }
__device__ __forceinline__ float sq4(const f32x4 x) { return (x[0] * x[0] + x[1] * x[1]) + (x[2] * x[2] + x[3] * x[3]); }

struct EpiProj {
    static constexpr bool PERM = true, AFTER_DRAIN = false, MIDK = false;
    bf16_t* Q; bf16_t* Kb; bf16_t* V; bf16_t* X3; float* kmean; const float* qg; const float* kg;
    __device__ __forceinline__ void operator()(const f32x4 (&acc)[2][2][4][2], const Unit& u, int wr, int wc, int fr, int fq) const {
        const int pn = u.pn;
        const int row0 = u.pm * BM + wr * 64 + fr;
        if (pn < 8) {
            const bool isq = pn < 4;
            const float* gp = isq ? qg : kg; const float gs = isq ? QSCALE : 1.0f;
            f32x4 gv[2][2];
#pragma unroll
            for (int bj = 0; bj < 2; ++bj)
#pragma unroll
                for (int n = 0; n < 2; ++n) gv[bj][n] = *(const f32x4*)(gp + 32 * bj + 8 * fq + 4 * n) * gs;
            const int head = (pn & 3) * 4 + wc;
            bf16_t* base = (isq ? Q : Kb) + head * 64 + 8 * fq;
            f32x4 cs[2][2];
#pragma unroll
            for (int bj = 0; bj < 2; ++bj)
#pragma unroll
                for (int n = 0; n < 2; ++n) cs[bj][n] = (f32x4){0.f, 0.f, 0.f, 0.f};
#pragma unroll
            for (int ai = 0; ai < 2; ++ai)
#pragma unroll
                for (int m = 0; m < 4; ++m) {
                    float ss = 0.f;
#pragma unroll
                    for (int bj = 0; bj < 2; ++bj)
#pragma unroll
                        for (int n = 0; n < 2; ++n) ss += sq4(acc[ai][bj][m][n]);
                    ss += shx<16>(ss); ss = xsum32(ss);
                    const float rn = rsqrtf(ss * (1.0f / 64.0f) + EPS);
                    const int tq = (u.pm & 7) * BM + ai * HALF + wr * 64 + m * 16 + fr;
                    bf16_t* rowp = isq ? base + (size_t)(row0 + ai * HALF + m * 16) * AW
                                       : Kb + ((size_t)(((u.pm >> 3) * NH + head) * (SEQ / 64) + (tq >> 6)) * 8 + fq) * 512 + (tq & 63) * 8;
#pragma unroll
                    for (int bj = 0; bj < 2; ++bj) {
                        const f32x4 v0 = acc[ai][bj][m][0] * rn * gv[bj][0], v1 = acc[ai][bj][m][1] * rn * gv[bj][1];
                        cs[bj][0] += v0; cs[bj][1] += v1;
                        *(u32x4*)(rowp + (isq ? 32 * bj : 2048 * bj)) = pack8(v0, v1);
                    }
                }
            if (!isq) {
                float* km = kmean + ((size_t)((u.pm >> 3) * NH + head) * NBLK + (u.pm & 7)) * HD + 8 * fq;
#pragma unroll
                for (int bj = 0; bj < 2; ++bj)
#pragma unroll
                    for (int n = 0; n < 2; ++n)
#pragma unroll
                        for (int e = 0; e < 4; ++e) {
                            float v = cs[bj][n][e];
                            v += shx<1>(v); v += shx<2>(v); v += shx<4>(v); v += shx<8>(v);
                            if (fr == 0) __hip_atomic_fetch_add(km + 32 * bj + 4 * n + e, v, __ATOMIC_RELAXED, __HIP_MEMORY_SCOPE_AGENT);
                        }
            }
        } else if (pn < 12) {
#pragma unroll
            for (int ai = 0; ai < 2; ++ai)
#pragma unroll
                for (int m = 0; m < 4; ++m) {
                    const int tq = (u.pm & 7) * BM + ai * HALF + wr * 64 + m * 16 + fr;
#pragma unroll
                    for (int bj = 0; bj < 2; ++bj) { const int head = (pn - 8) * 4 + 2 * bj + (wc >> 1);
                        *(u32x4*)(V + ((size_t)(((u.pm >> 3) * NH + head) * (SEQ / 64) + (tq >> 6)) * 8 + (wc & 1) * 4 + ((tq >> 4) & 3)) * 512 + (tq & 15) * 32 + 8 * fq) = pack8(acc[ai][bj][m][0], acc[ai][bj][m][1]); }
                }
        } else {
            const int b = u.pm >> 3;
#pragma unroll
            for (int bj = 0; bj < 2; ++bj) {
                const int ch = (pn - 12) * 256 + bj * HALF + wc * 32 + 8 * fq, g = ch >> 4, h0 = ch & 15;
#pragma unroll
                for (int ai = 0; ai < 2; ++ai)
#pragma unroll
                    for (int m = 0; m < 4; ++m) {
                        const int c16 = (u.pm & 7) * 16 + ai * 8 + wr * 4 + m;
                        bf16_t* p = X3 + ((size_t)(g * (BATCH * NCH) + b * NCH + c16)) * X3LD + fr * SC + h0;
                        *(u32x4*)p = pack8(acc[ai][bj][m][0], acc[ai][bj][m][1]);
                    }
            }
        }
    }
};

struct EpiGlu {
    static constexpr bool PERM = true, AFTER_DRAIN = false, MIDK = false;
    const bf16_t* act; bf16_t* out; const float* bias; float* rowsq;
    __device__ __forceinline__ void operator()(const f32x4 (&acc)[2][2][4][2], const Unit& u, int wr, int wc, int fr, int fq) const {
        const int row0 = u.pm * BM + wr * 64 + fr, col0 = u.pn * BM + wc * 32 + 8 * fq;
        f32x4 bv[2][2]; u32x4 av[2][4][2];
#pragma unroll
        for (int bj = 0; bj < 2; ++bj)
#pragma unroll
            for (int n = 0; n < 2; ++n) bv[bj][n] = *(const f32x4*)(bias + col0 + bj * HALF + 4 * n);
#pragma unroll
        for (int ai = 0; ai < 2; ++ai)
#pragma unroll
            for (int m = 0; m < 4; ++m) { const size_t offa = blk_off(u.pm, SW / BK, 4 * u.pn + (wc >> 1), ai * HALF + wr * 64 + m * 16 + fr, 32 * (wc & 1) + 8 * fq);
#pragma unroll
                for (int bj = 0; bj < 2; ++bj) av[ai][m][bj] = *(const u32x4*)(act + offa + (size_t)bj * 2 * BM * BK); }
        asm volatile("" ::: "memory");
#pragma unroll
        for (int ai = 0; ai < 2; ++ai)
#pragma unroll
            for (int m = 0; m < 4; ++m) {
                const int row = row0 + ai * HALF + m * 16;
                const size_t off = blk_off(u.pm, DM / BK, AW / BK + 4 * u.pn + (wc >> 1), row - u.pm * BM, 32 * (wc & 1) + 8 * fq);
                float ss = 0.f;
#pragma unroll
                for (int bj = 0; bj < 2; ++bj) {
                    const u32x4 a = av[ai][m][bj];
                    const f32x4 a0 = (f32x4){bflo(a.x), bfhi(a.x), bflo(a.y), bfhi(a.y)}, a1 = (f32x4){bflo(a.z), bfhi(a.z), bflo(a.w), bfhi(a.w)};
                    const f32x4 g0 = (acc[ai][bj][m][0] + bv[bj][0]) * (-LOG2E), g1 = (acc[ai][bj][m][1] + bv[bj][1]) * (-LOG2E);
                    f32x4 o0, o1;
#pragma unroll
                    for (int e = 0; e < 4; ++e) { o0[e] = a0[e] * __builtin_amdgcn_rcpf(1.0f + __builtin_amdgcn_exp2f(g0[e])); o1[e] = a1[e] * __builtin_amdgcn_rcpf(1.0f + __builtin_amdgcn_exp2f(g1[e])); }
                    const u32x4 w = pack8(o0, o1);
                    *(u32x4*)(out + off + (size_t)bj * 2 * BM * BK) = w;
                    ss += (bflo(w.x) * bflo(w.x) + bfhi(w.x) * bfhi(w.x)) + (bflo(w.y) * bflo(w.y) + bfhi(w.y) * bfhi(w.y)) + (bflo(w.z) * bflo(w.z) + bfhi(w.z) * bfhi(w.z)) + (bflo(w.w) * bflo(w.w) + bfhi(w.w) * bfhi(w.w));
                }
                ss += shx<16>(ss); ss = xsum32(ss);
                if (fq == 0) __hip_atomic_fetch_add(rowsq + row, ss, __ATOMIC_RELAXED, __HIP_MEMORY_SCOPE_AGENT);
            }
    }
};

struct EpiWout {
    static constexpr bool PERM = true, AFTER_DRAIN = false, MIDK = true;
    const float* x; bf16_t* x1b; float* rowsq; const float* sqa; const float* sqs;
    __device__ __forceinline__ void mid(f32x4 (&acc)[2][2][4][2], const Unit& u, int wr, int wc, int fr, int fq) const {
        int row0 = u.pm * BM + wr * 64 + fr; asm volatile("" : "+v"(row0));
#pragma unroll
        for (int ai = 0; ai < 2; ++ai)
#pragma unroll
            for (int m = 0; m < 4; ++m) { const int row = row0 + ai * HALF + m * 16;
                const float f = rsqrtf(sqa[row] * (1.0f / (float)AW) + EPS) * sqrtf(sqs[row] * (1.0f / (float)SW) + EPS);
#pragma unroll
                for (int bj = 0; bj < 2; ++bj)
#pragma unroll
                    for (int n = 0; n < 2; ++n) acc[ai][bj][m][n] *= f; }
    }
    __device__ __forceinline__ void operator()(const f32x4 (&acc)[2][2][4][2], const Unit& u, int wr, int wc, int fr, int fq) const {
        const int row0 = u.pm * BM + wr * 64 + fr, col0 = u.pn * BM + wc * 32 + 8 * fq;
        float rs[2][4];
#pragma unroll
        for (int ai = 0; ai < 2; ++ai)
#pragma unroll
            for (int m = 0; m < 4; ++m) rs[ai][m] = rsqrtf(sqs[row0 + ai * HALF + m * 16] * (1.0f / (float)SW) + EPS);
#pragma unroll
        for (int ai = 0; ai < 2; ++ai) {
            f32x4 xv[4][2][2];
#pragma unroll
            for (int m = 0; m < 4; ++m) { const size_t off = (size_t)(row0 + ai * HALF + m * 16) * DM + col0;
#pragma unroll
                for (int bj = 0; bj < 2; ++bj) { xv[m][bj][0] = *(const f32x4*)(x + off + bj * HALF); xv[m][bj][1] = *(const f32x4*)(x + off + bj * HALF + 4); } }
            asm volatile("" ::: "memory");
#pragma unroll
            for (int m = 0; m < 4; ++m) {
                const int row = row0 + ai * HALF + m * 16; const size_t offb = blk_off(u.pm, DM / BK, 4 * u.pn + (wc >> 1), row - u.pm * BM, 32 * (wc & 1) + 8 * fq);
                float ss = 0.f;
#pragma unroll
                for (int bj = 0; bj < 2; ++bj) {
                    const f32x4 v0 = acc[ai][bj][m][0] * rs[ai][m] + xv[m][bj][0], v1 = acc[ai][bj][m][1] * rs[ai][m] + xv[m][bj][1];
                    *(u32x4*)(x1b + offb + (size_t)bj * 2 * BM * BK) = pack8(v0, v1);
                    ss += sq4(v0) + sq4(v1);
                }
                ss += shx<16>(ss); ss = xsum32(ss);
                if (fq == 0) __hip_atomic_fetch_add(rowsq + row, ss, __ATOMIC_RELAXED, __HIP_MEMORY_SCOPE_AGENT);
            }
            asm volatile("" ::: "memory");
        }
    }
};

struct EpiFF1 {
    static constexpr bool PERM = true, AFTER_DRAIN = false, MIDK = false;
    bf16_t* hid; const float* rowsq;
    __device__ __forceinline__ void operator()(const f32x4 (&acc)[2][2][4][2], const Unit& u, int wr, int wc, int fr, int fq) const {
        const int row0 = u.pm * BM + wr * 64 + fr;
        float r2[2][4];
#pragma unroll
        for (int ai = 0; ai < 2; ++ai)
#pragma unroll
            for (int m = 0; m < 4; ++m) r2[ai][m] = __builtin_amdgcn_rcpf(rowsq[row0 + ai * HALF + m * 16] * (1.0f / (float)DM) + EPS);
        asm volatile("" ::: "memory");
#pragma unroll
        for (int ai = 0; ai < 2; ++ai)
#pragma unroll
            for (int m = 0; m < 4; ++m) {
                bf16_t* rowp = hid + blk_off(u.pm, DFF / BK, 4 * u.pn + wc, ai * HALF + wr * 64 + m * 16 + fr, 8 * fq);
#pragma unroll
                for (int bj = 0; bj < 2; ++bj) {
                    f32x4 v0 = acc[ai][bj][m][0], v1 = acc[ai][bj][m][1];
#pragma unroll
                    for (int e = 0; e < 4; ++e) { v0[e] = relu1(v0[e]); v1[e] = relu1(v1[e]); }
                    v0 = (v0 * v0) * r2[ai][m]; v1 = (v1 * v1) * r2[ai][m];
                    *(u32x4*)(rowp + 512 * bj) = pack8(v0, v1);
                }
            }
    }
};

struct EpiFF2 {
    static constexpr bool PERM = true, AFTER_DRAIN = false, MIDK = false;
    float* out; const bf16_t* x1b;
    __device__ __forceinline__ void operator()(const f32x4 (&acc)[2][2][4][2], const Unit& u, int wr, int wc, int fr, int fq) const {
        const int row0 = u.pm * BM + wr * 64 + fr, col0 = u.pn * BM + wc * 32 + 8 * fq;
        u32x4 av[2][4][2];
#pragma unroll
        for (int ai = 0; ai < 2; ++ai)
#pragma unroll
            for (int m = 0; m < 4; ++m) { const bf16_t* xp = x1b + blk_off(u.pm, DM / BK, 4 * u.pn + (wc >> 1), ai * HALF + wr * 64 + m * 16 + fr, 32 * (wc & 1) + 8 * fq);
#pragma unroll
                for (int bj = 0; bj < 2; ++bj) av[ai][m][bj] = *(const u32x4*)(xp + (size_t)bj * 2 * BM * BK); }
        asm volatile("" ::: "memory");
#pragma unroll
        for (int ai = 0; ai < 2; ++ai)
#pragma unroll
            for (int m = 0; m < 4; ++m) {
                float* rowp = out + (size_t)(row0 + ai * HALF + m * 16) * DM + col0;
#pragma unroll
                for (int bj = 0; bj < 2; ++bj) { const u32x4 a = av[ai][m][bj];
                    *(f32x4*)(rowp + bj * HALF) = acc[ai][bj][m][0] + (f32x4){bflo(a.x), bfhi(a.x), bflo(a.y), bfhi(a.y)};
                    *(f32x4*)(rowp + bj * HALF + 4) = acc[ai][bj][m][1] + (f32x4){bflo(a.z), bfhi(a.z), bflo(a.w), bfhi(a.w)}; }
            }
    }
};

struct GroupOrder {
    int G, c;
    __device__ __forceinline__ bool next(int i, Unit& u) const { const int n = i * G + c; if (n >= SG * 8) return false; u.pm = n; u.pn = n >> 3; return true; }
    __device__ __forceinline__ void a_ready(const Unit&) const {}
    __device__ __forceinline__ void done(const Unit&) const {}
};
struct EpiSsmL {
    static constexpr bool PERM = false, AFTER_DRAIN = false, MIDK = false;
    float* L;
    __device__ __forceinline__ void operator()(const f32x4 (&acc)[2][2][4][2], const Unit& u, int wr, int wc, int fr, int fq) const {
        const int row0 = u.pm * BM + wr * 64 + fr, col0 = wc * 32 + 4 * fq;
#pragma unroll
        for (int ai = 0; ai < 2; ++ai)
#pragma unroll
            for (int m = 0; m < 4; ++m) { float* rowp = L + (size_t)(row0 + ai * HALF + m * 16) * (2 * SP) + col0;
#pragma unroll
                for (int n = 0; n < 2; ++n) *(f32x4*)(rowp + n * 16) = acc[ai][0][m][n]; }
    }
};
__device__ __forceinline__ float gelu_tanh_e(float y) { const float z = y * (1.0f + 0.044715f * y * y) * (-2.0f * 0.7978845608028654f * LOG2E); return y * __builtin_amdgcn_rcpf(1.0f + __builtin_amdgcn_exp2f(z)); }
struct EpiSsmY {
    static constexpr bool PERM = true, AFTER_DRAIN = false, MIDK = false;
    bf16_t* ACT;
    __device__ __forceinline__ void operator()(const f32x4 (&acc)[2][2][4][2], const Unit& u, int wr, int wc, int fr, int fq) const {
        const int g = u.pn, rloc0 = (u.pm & 7) * BM + wr * 64 + fr;
        int cpart[2];
#pragma unroll
        for (int bj = 0; bj < 2; ++bj) { const int col = bj * HALF + wc * 32 + 8 * fq, i = col >> 4, cin = (g & 3) * SC + (col & 15);
            cpart[bj] = (cin >> 5) * 512 + (((i * 64 + (cin & 31) * 2) ^ (((i >> 3) & 1) << 5)) >> 1); }
#pragma unroll
        for (int ai = 0; ai < 2; ++ai)
#pragma unroll
            for (int m = 0; m < 4; ++m) { int rl = rloc0 + ai * HALF + m * 16; asm volatile("" : "+v"(rl));
                const int b = rl >> 7, c = rl & 127;
                bf16_t* base = ACT + ((size_t)(b * 8 + (c >> 4)) * (SW / BK) + (g >> 2)) * (BM * BK) + ((c >> 3) & 1) * 8192 + (c & 7) * 1024;
#pragma unroll
                for (int bj = 0; bj < 2; ++bj) {
                    f32x4 v0 = acc[ai][bj][m][0], v1 = acc[ai][bj][m][1];
#pragma unroll
                    for (int e2 = 0; e2 < 4; ++e2) { v0[e2] = gelu_tanh_e(v0[e2]); v1[e2] = gelu_tanh_e(v1[e2]); }
                    *(u32x4*)(base + cpart[bj]) = pack8(v0, v1); } }
    }
};
}
#include <hip/hip_bf16.h>
#include <cmath>
namespace attn_body {
using bf16=__hip_bfloat16;
using bf16x8=__attribute__((ext_vector_type(8)))short;
using s16x4=__attribute__((ext_vector_type(4)))short;
using f32x16=__attribute__((ext_vector_type(16)))float;
using u32x4=__attribute__((ext_vector_type(4)))unsigned;
using f32x4v=__attribute__((ext_vector_type(4)))float;
constexpr int BATCH=16,NHEAD=16,SEQ=2048,D=64,DM=NHEAD*D;
constexpr int NW=8,QBLK=32,QB=QBLK*NW,KVBLK=64,NQB=SEQ/QB;
constexpr int ATTN_PITCH=DM, ATTN_UNIT_ROWS=QB, OPITCH=2048+64;
__device__ __forceinline__ int crow(int r,int hi){return (r&3)+8*(r>>2)+4*hi;}
#define SBAR() __builtin_amdgcn_sched_barrier(0)
__device__ __forceinline__ void cmask(f32x16&p0,f32x16&p1,int jb,int qrel,int hi){
  const float NEG=-4096.0f; int kb=64*jb+4*hi;
  #pragma unroll
  for(int r=0;r<16;++r){int kv=kb+(r&3)+8*(r>>2); if(kv>qrel)p0[r]=NEG; if(kv+32>qrel)p1[r]=NEG;}
}

constexpr int NSLOT=3, SLOTB=8192;
constexpr int LDS_K=0, LDS_V=NSLOT*SLOTB, LDS_WS=2*NSLOT*SLOTB, LDS_OST=LDS_WS+NW*64*4, LDS_BYTES=LDS_OST+NW*4096;
constexpr float C2=0.125f*1.4426950408889634f;
__device__ __forceinline__ void glds16(const void*gsrc,unsigned lds_dst){unsigned keep;
  asm volatile("s_mov_b32 %0, m0\n\ts_mov_b32 m0, %2\n\ts_nop 0\n\tglobal_load_lds_dwordx4 %1, off\n\ts_mov_b32 m0, %0":"=&s"(keep):"v"(gsrc),"s"(lds_dst):"memory");}
__device__ __forceinline__ float max3f(float a,float b,float c){float r;asm("v_max3_f32 %0, %1, %2, %3":"=v"(r):"v"(a),"v"(b),"v"(c));return r;}
__device__ __forceinline__ float max2f(float a,float b){float r;asm("v_max_f32_e32 %0, %1, %2":"=v"(r):"v"(a),"v"(b));return r;}
__device__ __forceinline__ float fadd_s(float a,float b){float r;asm("v_add_f32_e32 %0, %1, %2":"=v"(r):"v"(a),"v"(b));return r;}
__device__ __forceinline__ float fsub_s(float a,float b){float r;asm("v_sub_f32_e32 %0, %1, %2":"=v"(r):"v"(a),"v"(b));return r;}
typedef float f32x2_t __attribute__((ext_vector_type(2))); typedef __bf16 bf16x2_t __attribute__((ext_vector_type(2)));
__device__ __forceinline__ unsigned cvtpk_s(float lo,float hi){f32x2_t v={lo,hi};bf16x2_t b=__builtin_convertvector(v,bf16x2_t);return __builtin_bit_cast(unsigned,b);}
#define WAIT_BAR(N) asm volatile("s_waitcnt vmcnt(" #N ") lgkmcnt(0)\n\ts_barrier":::"memory")

__device__ __forceinline__ void qkt(f32x16&p0,f32x16&p1,const char*Kslot,const bf16x8*qr,int r32,int hi){
  const char*kb=Kslot+hi*1024+r32*16;
  #pragma unroll
  for(int d0=0;d0<4;++d0){
    const bf16x8 b0=*reinterpret_cast<const bf16x8*>(kb+d0*2048);
    const bf16x8 b1=*reinterpret_cast<const bf16x8*>(kb+d0*2048+512);
    p0=__builtin_amdgcn_mfma_f32_32x32x16_bf16(b0,qr[d0],p0,0,0,0);p1=__builtin_amdgcn_mfma_f32_32x32x16_bf16(b1,qr[d0],p1,0,0,0);}
}
typedef __attribute__((address_space(3))) const char* lds_cptr;
typedef short v4i16_t __attribute__((ext_vector_type(4)));
__device__ __forceinline__ void kload8(bf16x8*kf,lds_cptr kp){
  kf[0]=*(const __attribute__((address_space(3))) bf16x8*)(kp);      kf[1]=*(const __attribute__((address_space(3))) bf16x8*)(kp+512);
  kf[2]=*(const __attribute__((address_space(3))) bf16x8*)(kp+2048); kf[3]=*(const __attribute__((address_space(3))) bf16x8*)(kp+2560);
  kf[4]=*(const __attribute__((address_space(3))) bf16x8*)(kp+4096); kf[5]=*(const __attribute__((address_space(3))) bf16x8*)(kp+4608);
  kf[6]=*(const __attribute__((address_space(3))) bf16x8*)(kp+6144); kf[7]=*(const __attribute__((address_space(3))) bf16x8*)(kp+6656);
}
__device__ __forceinline__ void kload2(bf16x8*kf,lds_cptr kp,int j){ kf[2*j]=*(const __attribute__((address_space(3))) bf16x8*)(kp+j*2048); kf[2*j+1]=*(const __attribute__((address_space(3))) bf16x8*)(kp+j*2048+512); }
__device__ __forceinline__ s16x4 vtr(lds_cptr p){ return __builtin_bit_cast(s16x4,__builtin_amdgcn_ds_read_tr16_b64_v4i16((__attribute__((address_space(3))) v4i16_t*)p)); }
__device__ __forceinline__ float rowmax(const f32x16&p0,const f32x16&p1){
  float a=max3f(p0[0],p0[1],p1[0]),b=max3f(p0[2],p0[3],p1[1]);a=max3f(a,p1[2],p1[3]);
  #pragma unroll
  for(int r=4;r<16;r+=4){a=max3f(a,p0[r],p0[r+1]);b=max3f(b,p0[r+2],p0[r+3]);a=max3f(a,p1[r],p1[r+1]);b=max3f(b,p1[r+2],p1[r+3]);}
  const float m=max2f(a,b);
  auto rr=__builtin_amdgcn_permlane32_swap(__float_as_uint(m),__float_as_uint(m),false,false);
  return max2f(__uint_as_float(rr[0]),__uint_as_float(rr[1]));
}
__device__ __forceinline__ void pv(f32x16*o,int vb,bf16x8 pa0,bf16x8 pa1,bf16x8 pa2,bf16x8 pa3){
  #pragma unroll
  for(int d0=0;d0<2;++d0){s16x4 lo[4],hi[4];
    #pragma unroll
    for(int ks=0;ks<4;++ks){
      asm volatile("ds_read_b64_tr_b16 %0,%1 offset:%c2":"=&v"(lo[ks]):"v"(vb),"i"(d0*4096+ks*1024):"memory");
      asm volatile("ds_read_b64_tr_b16 %0,%1 offset:%c2":"=&v"(hi[ks]):"v"(vb),"i"(d0*4096+ks*1024+512):"memory");}
    asm volatile("s_waitcnt lgkmcnt(0)":::"memory");SBAR();
    #define PK(k) (bf16x8){lo[k][0],lo[k][1],lo[k][2],lo[k][3],hi[k][0],hi[k][1],hi[k][2],hi[k][3]}
    o[d0]=__builtin_amdgcn_mfma_f32_32x32x16_bf16(pa0,PK(0),o[d0],0,0,0);
    o[d0]=__builtin_amdgcn_mfma_f32_32x32x16_bf16(pa1,PK(1),o[d0],0,0,0);
    o[d0]=__builtin_amdgcn_mfma_f32_32x32x16_bf16(pa2,PK(2),o[d0],0,0,0);
    o[d0]=__builtin_amdgcn_mfma_f32_32x32x16_bf16(pa3,PK(3),o[d0],0,0,0);
    #undef PK
  }
}

#ifndef ATTN_STORE16
#define ATTN_STORE16(p,v) (*(u32x4*)(p)=(v))
#endif
template<int THRL> __device__ __forceinline__ void attn_unit(int b,int h,int qb,const bf16*Q,const bf16*__restrict__ K,const bf16*__restrict__ V,bf16*O,const float*kmean,float*rowsq,char*shm,bool pref,bool hn,int nb,int nh,int nqb,bf16x8(&qn)[4]){
  int tid_=threadIdx.x; asm volatile("":"+v"(tid_)); const int tid=tid_,lane=tid&63,r32=lane&31,hi=lane>>5; const int wid=__builtin_amdgcn_readfirstlane(tid>>6);
  const long rowbase=(long)b*SEQ; const int q0=qb*QB;
  const bf16*Qw=Q+(rowbase+q0+wid*QBLK)*DM+h*D;
  const bf16*Kh=K+(long)(b*NHEAD+h)*(SEQ*D),*Vh=V+(long)(b*NHEAD+h)*(SEQ*D);
  const unsigned lds0=(unsigned)(uintptr_t)shm;
  float*wsf=(float*)(shm+LDS_WS)+wid*64;
  const bf16*ksrc=Kh+wid*512+lane*8;
  const bf16*vsrc=Vh+wid*512+lane*8;
  const unsigned kdst=lds0+LDS_K+wid*1024, vdst=lds0+LDS_V+wid*1024;
  #define DMA_K(t,slot) glds16(ksrc+(long)(NTF-1-(t))*(KVBLK*D),(unsigned)__builtin_amdgcn_readfirstlane(kdst+(slot)))
  #define DMA_V(t,slot) glds16(vsrc+(long)(NTF-1-(t))*(KVBLK*D),(unsigned)__builtin_amdgcn_readfirstlane(vdst+(slot)))
  const int vb0=(int)(lds0+LDS_V)+((lane>>4)&1)*32+(lane&3)*8+(4*hi+((lane&15)>>2))*64;
  const char*Kbase=shm+LDS_K; bf16x8 kf[8];
  const lds_cptr shm3=(lds_cptr)shm; const lds_cptr kp0=shm3+LDS_K+hi*1024+r32*16; const lds_cptr vp0=shm3+LDS_V+((lane>>4)&1)*32+(lane&3)*8+(4*hi+((lane&15)>>2))*64;
  const float sl2=__builtin_amdgcn_exp2f(-0.5f*(float)(h+1))*1.4426950408889634f;
  const int NTF=(q0+QB)/KVBLK;
  int npt_=(int)((182.0f/sl2+63.0f)*(1.0f/64.0f)); npt_+=npt_&1; npt_=__builtin_amdgcn_readfirstlane(npt_);
  const int NT=(4+npt_<NTF)?4+npt_:NTF;
  if(!pref){DMA_K(0,0);DMA_V(0,0);DMA_K(1,SLOTB);}
  bf16x8 qr[4];
  #pragma unroll
  for(int d0=0;d0<4;++d0)qr[d0]=pref?qn[d0]:*reinterpret_cast<const bf16x8*>(&Qw[(long)r32*DM+d0*16+hi*8]);
  float mhat=0.f,l_reg=0.f;f32x16 o[2];o[0]=f32x16{};o[1]=f32x16{};
  unsigned selm=0u;
  if(qb>0){ float gate[7];
    #pragma unroll
    for(int j=0;j<7;++j){ float sg=0.f;
      if(j<qb){ const float*km=kmean+((long)(b*NHEAD+h)*8+j)*D+hi*8;
        #pragma unroll
        for(int d0=0;d0<4;++d0){ const f32x4v ka=*reinterpret_cast<const f32x4v*>(km+d0*16),kb2=*reinterpret_cast<const f32x4v*>(km+d0*16+4); const bf16x8 qv=qr[d0];
          #define QF(i) __builtin_bit_cast(float,((unsigned)(unsigned short)qv[i])<<16)
          sg+=(QF(0)*ka[0]+QF(1)*ka[1])+(QF(2)*ka[2]+QF(3)*ka[3])+(QF(4)*kb2[0]+QF(5)*kb2[1])+(QF(6)*kb2[2]+QF(7)*kb2[3]);
          #undef QF
        }
        sg=xsum32(sg); }
      gate[j]=sg; }
    #pragma unroll
    for(int j=0;j<7;++j) if(j<qb){ int cnt=0;
      #pragma unroll
      for(int i=0;i<7;++i) if(i!=j&&i<qb) cnt+=(gate[i]>gate[j]||(gate[i]==gate[j]&&i<j))?1:0;
      if(cnt<3) selm|=1u<<j; } }
  const float hib=sl2*(float)(4*hi);
  #define CINIT(C0,C1,t) do{ const int t_=(t); const bool on_=(t_<4)||(((selm>>((NTF-1-t_)>>2))&1u)!=0u); \
    const float bs_=on_?(sl2*(float)(64*(3-t_))+hib-mhat):-4096.0f; \
    const f32x2_t sv_={sl2,sl2},bv_={bs_,bs_},dv_={32.0f*sl2,32.0f*sl2}; \
    _Pragma("unroll") for(int r=0;r<16;r+=2){ const float kc_=(float)((r&3)+8*(r>>2)); const f32x2_t kk_={kc_,kc_+1.0f}; const f32x2_t r0_=sv_*kk_+bv_, r1_=r0_+dv_; \
      C0[r]=r0_.x; C0[r+1]=r0_.y; C1[r]=r1_.x; C1[r+1]=r1_.y; } }while(0)
  const int qrel=wid*QBLK+r32;
  #define CMASK(P0,P1,t) do{int jb_=3-(t); if(jb_>=0)cmask(P0,P1,jb_,qrel,hi);}while(0)
  bool resc=false;
  #define START(P0,P1) do{ const float rm=rowmax(P0,P1); resc=false; \
    { const float dl=rm; mhat=fadd_s(mhat,dl); \
      _Pragma("unroll") for(int r=0;r<16;++r){P0[r]=fsub_s(P0[r],dl);P1[r]=fsub_s(P1[r],dl);} \
      } \
    _Pragma("unroll") for(int r=0;r<16;++r)P0[r]=__builtin_amdgcn_exp2f(P0[r]); }while(0)
  #define RESC() do{ if(resc){ asm volatile("s_waitcnt lgkmcnt(0)":::"memory"); \
      _Pragma("unroll") for(int d_=0;d_<2;++d_) _Pragma("unroll") for(int r=0;r<16;++r)o[d_][r]*=wsf[crow(r,hi)]; } }while(0)
  f32x16 pA0,pA1,pB0,pB1;
  int sl_prev=0,sl_cur=0,sl_next=SLOTB;
  #define ROT() do{sl_prev=sl_cur;sl_cur=sl_next;sl_next=(sl_next==(NSLOT-1)*SLOTB)?0:sl_next+SLOTB;}while(0)
  DMA_K(2,2*SLOTB);
  WAIT_BAR(3);
  CINIT(pA0,pA1,0);qkt(pA0,pA1,Kbase,qr,r32,hi);asm volatile("s_nop 15\n\ts_nop 7":"+v"(pA0),"+v"(pA1));CMASK(pA0,pA1,0);
  START(pA0,pA1);
  _Pragma("unroll") for(int r=0;r<16;++r)pA1[r]=__builtin_amdgcn_exp2f(pA1[r]);
  WAIT_BAR(0);
  DMA_K(3,0);DMA_V(1,SLOTB);
  ROT();
  kload8(kf,kp0+sl_cur);
  WAIT_BAR(2);
  s16x4 vlo[8],vhi[8]; u32x4 pw0,pw1,pw2,pw3;
  #define PKW(P,B) cvtpk_s(P[B],P[B+1])
  #define PAF(k) __builtin_bit_cast(bf16x8,pw##k)
  #define VFR(i) (bf16x8){vlo[i][0],vlo[i][1],vlo[i][2],vlo[i][3],vhi[i][0],vhi[i][1],vhi[i][2],vhi[i][3]}
  #define PIN(x) asm volatile("":"+v"(x))
  #define MX3(a,b,c) __builtin_fmaxf(__builtin_fmaxf((a),(b)),(c))
  #define GAPA(MF,A0,A1,A2,A3,W0,W1,PW) do{ MF; sacc+=A0; sacc+=A1; sacc+=A2; sacc+=A3; PIN(sacc); W0; W1; PIN(PW); SBAR(); }while(0)
  #define EX(v) __builtin_amdgcn_exp2f(v)
  #define GAPB(MF,X,B) do{ MF; X[B]=EX(X[B]); X[B+1]=EX(X[B+1]); X[B+2]=EX(X[B+2]); X[B+3]=EX(X[B+3]); PIN(X); SBAR(); }while(0)
  #define VRD(i) do{ vlo[i]=vtr(vp_+(((i)>>2)*4096+((i)&3)*1024)); vhi[i]=vtr(vp_+(((i)>>2)*4096+((i)&3)*1024+512)); }while(0)
  #define KRD(G,j) do{ if(G){ kload2(kf,kp0+sl_next,j); SBAR(); } }while(0)
  #define STEP(C0,C1,P0,P1,t,GK,GV,GL) do{ SBAR(); CINIT(C0,C1,t); SBAR(); \
    const lds_cptr vp_=vp0+sl_prev; \
    VRD(0); SBAR(); float sacc=(P0[0]+P0[1]); \
    GAPA(C0=__builtin_amdgcn_mfma_f32_32x32x16_bf16(kf[0],qr[0],C0,0,0,0), P0[2],P0[3],P0[4],P0[5],     pw0[0]=PKW(P0,0), pw0[1]=PKW(P0,2), pw0); \
    VRD(4); SBAR(); GAPA(C1=__builtin_amdgcn_mfma_f32_32x32x16_bf16(kf[1],qr[0],C1,0,0,0), P0[6],P0[7],P0[8],P0[9],     pw0[2]=PKW(P0,4), pw0[3]=PKW(P0,6), pw0); \
    VRD(1); SBAR(); GAPA(C0=__builtin_amdgcn_mfma_f32_32x32x16_bf16(kf[2],qr[1],C0,0,0,0),   P0[10],P0[11],P0[12],P0[13], pw1[0]=PKW(P0,8), pw1[1]=PKW(P0,10), pw1); \
    VRD(5); SBAR(); GAPA(C1=__builtin_amdgcn_mfma_f32_32x32x16_bf16(kf[3],qr[1],C1,0,0,0),   P0[14],P0[15],P1[0],P1[1],   pw1[2]=PKW(P0,12),pw1[3]=PKW(P0,14), pw1); \
    VRD(2); SBAR(); GAPA(C0=__builtin_amdgcn_mfma_f32_32x32x16_bf16(kf[4],qr[2],C0,0,0,0),   P1[2],P1[3],P1[4],P1[5],     pw2[0]=PKW(P1,0), pw2[1]=PKW(P1,2), pw2); \
    VRD(6); SBAR(); GAPA(C1=__builtin_amdgcn_mfma_f32_32x32x16_bf16(kf[5],qr[2],C1,0,0,0),   P1[6],P1[7],P1[8],P1[9],     pw2[2]=PKW(P1,4), pw2[3]=PKW(P1,6), pw2); \
    VRD(3); SBAR(); GAPA(C0=__builtin_amdgcn_mfma_f32_32x32x16_bf16(kf[6],qr[3],C0,0,0,0),   P1[10],P1[11],P1[12],P1[13], pw3[0]=PKW(P1,8), pw3[1]=PKW(P1,10), pw3); \
    VRD(7); SBAR(); GAPA(C1=__builtin_amdgcn_mfma_f32_32x32x16_bf16(kf[7],qr[3],C1,0,0,0),   P1[14],P1[15],0.f,0.f,       pw3[2]=PKW(P1,12),pw3[3]=PKW(P1,14), pw3); \
    l_reg+=sacc; \
    if(GK){DMA_K((t)+3,sl_cur);} if(GV){DMA_V((t)+1,sl_next);} \
    CMASK(C0,C1,t); \
    { float a=MX3(C0[0],C0[1],C1[0]),b=MX3(C0[2],C0[3],C1[1]); a=MX3(a,C1[2],C1[3]); \
      _Pragma("unroll") for(int r=4;r<16;r+=4){a=MX3(a,C0[r],C0[r+1]);b=MX3(b,C0[r+2],C0[r+3]);a=MX3(a,C1[r],C1[r+1]);b=MX3(b,C1[r+2],C1[r+3]);} \
      float rm=__builtin_fmaxf(a,b); { auto rr=__builtin_amdgcn_permlane32_swap(__float_as_uint(rm),__float_as_uint(rm),false,false); rm=__builtin_fmaxf(__uint_as_float(rr[0]),__uint_as_float(rr[1])); } \
      resc=false; \
      if(__builtin_expect(__any(rm>(float)THRL),0)){ const float dl=__builtin_fmaxf(rm,0.f); mhat+=dl; \
        _Pragma("unroll") for(int r=0;r<16;++r){C0[r]-=dl;C1[r]-=dl;} \
        const float f=__builtin_amdgcn_exp2f(-dl); l_reg*=f; if(hi==0)wsf[r32]=f; resc=true; } } \
    SBAR(); \
    GAPB(o[0]=__builtin_amdgcn_mfma_f32_32x32x16_bf16(PAF(0),VFR(0),o[0],0,0,0), C0,0); \
    GAPB(o[1]=__builtin_amdgcn_mfma_f32_32x32x16_bf16(PAF(0),VFR(4),o[1],0,0,0), C0,4); \
    KRD(GL,0); GAPB(o[0]=__builtin_amdgcn_mfma_f32_32x32x16_bf16(PAF(1),VFR(1),o[0],0,0,0), C0,8); \
    KRD(GL,1); GAPB(o[1]=__builtin_amdgcn_mfma_f32_32x32x16_bf16(PAF(1),VFR(5),o[1],0,0,0), C0,12); \
    KRD(GL,2); GAPB(o[0]=__builtin_amdgcn_mfma_f32_32x32x16_bf16(PAF(2),VFR(2),o[0],0,0,0), C1,0); \
    KRD(GL,3); GAPB(o[1]=__builtin_amdgcn_mfma_f32_32x32x16_bf16(PAF(2),VFR(6),o[1],0,0,0), C1,4); \
    GAPB(o[0]=__builtin_amdgcn_mfma_f32_32x32x16_bf16(PAF(3),VFR(3),o[0],0,0,0), C1,8); \
    GAPB(o[1]=__builtin_amdgcn_mfma_f32_32x32x16_bf16(PAF(3),VFR(7),o[1],0,0,0), C1,12); \
    }while(0)
  int t=1;
  for(;t+5<NT;t+=2){
    STEP(pB0,pB1,pA0,pA1,t,true,true,true);     WAIT_BAR(2); RESC(); ROT();
    STEP(pA0,pA1,pB0,pB1,t+1,true,true,true);   WAIT_BAR(2); RESC(); ROT();
  }
  #define ENDW(tt) do{ if((tt)+3<NT){WAIT_BAR(2);} else if((tt)+2<NT){WAIT_BAR(1);} else {WAIT_BAR(0);} }while(0)
  for(;t+1<NT;t+=2){
    STEP(pB0,pB1,pA0,pA1,t,(t+3<NT),(t+1<NT),(t+1<NT));       ENDW(t);   RESC(); ROT();
    STEP(pA0,pA1,pB0,pB1,t+1,(t+4<NT),(t+2<NT),(t+2<NT));     ENDW(t+1); RESC(); ROT();
  }
  STEP(pB0,pB1,pA0,pA1,NT-1,false,false,false); RESC();
  { float sacc=pB0[0]+pB0[1]; _Pragma("unroll") for(int r=2;r<16;++r)sacc+=pB0[r]; _Pragma("unroll") for(int r=0;r<16;++r)sacc+=pB1[r]; l_reg+=sacc;
    pw0=(u32x4){PKW(pB0,0),PKW(pB0,2),PKW(pB0,4),PKW(pB0,6)};pw1=(u32x4){PKW(pB0,8),PKW(pB0,10),PKW(pB0,12),PKW(pB0,14)};pw2=(u32x4){PKW(pB1,0),PKW(pB1,2),PKW(pB1,4),PKW(pB1,6)};pw3=(u32x4){PKW(pB1,8),PKW(pB1,10),PKW(pB1,12),PKW(pB1,14)};
    SBAR(); pv(o,vb0+sl_cur,PAF(0),PAF(1),PAF(2),PAF(3)); }
  if(hn){ asm volatile("s_waitcnt lgkmcnt(0)\n\ts_barrier":::"memory");
    const bf16*nK=K+(long)(nb*NHEAD+nh)*(SEQ*D)+wid*512+lane*8,*nV=V+(long)(nb*NHEAD+nh)*(SEQ*D)+wid*512+lane*8; const int nNTF=(nqb*QB+QB)/KVBLK;
    glds16(nK+(long)(nNTF-1)*(KVBLK*D),(unsigned)__builtin_amdgcn_readfirstlane(kdst)); glds16(nV+(long)(nNTF-1)*(KVBLK*D),(unsigned)__builtin_amdgcn_readfirstlane(vdst)); glds16(nK+(long)(nNTF-2)*(KVBLK*D),(unsigned)__builtin_amdgcn_readfirstlane(kdst+SLOTB));
    const bf16*nQ=Q+((long)nb*SEQ+nqb*QB+wid*QBLK)*DM+nh*D;
    #pragma unroll
    for(int d0=0;d0<4;++d0)qn[d0]=*reinterpret_cast<const bf16x8*>(&nQ[(long)r32*DM+d0*16+hi*8]); }
  #undef PKW
  #undef PAF
  #undef VFR
  #undef PIN
  #undef MX3
  #undef GAPA
  #undef GAPB
  #undef EX
  #undef VRD
  #undef KRD
  #undef STEP
  #undef ENDW
  {auto rr=__builtin_amdgcn_permlane32_swap(__float_as_uint(l_reg),__float_as_uint(l_reg),false,false);l_reg=__uint_as_float(rr[0])+__uint_as_float(rr[1]);}
  if(hi==0)wsf[32+r32]=l_reg;asm volatile("s_waitcnt lgkmcnt(0)":::"memory");
  float rli[16];
  #pragma unroll
  for(int r=0;r<16;++r)rli[r]=__builtin_amdgcn_rcpf(wsf[32+crow(r,hi)]);
  bf16*Ow=O+(((rowbase+q0)>>8)*32+h)*16384L; float*sqw=rowsq+(rowbase+q0+wid*QBLK);
  { bf16*stg=(bf16*)(shm+LDS_OST)+wid*2048;
    #pragma unroll
    for(int r=0;r<16;++r){const int orow=crow(r,hi);
      #pragma unroll
      for(int d0=0;d0<2;++d0)stg[orow*64+d0*32+r32]=__float2bfloat16(o[d0][r]*rli[r]);}
    asm volatile("s_waitcnt lgkmcnt(0)":::"memory");
    #pragma unroll
    for(int i=0;i<4;++i){const int row=i*8+(lane>>3),ch=lane&7; const u32x4 v=*(const u32x4*)(stg+row*64+ch*8); ATTN_STORE16(Ow+pg8::img_in(wid*QBLK+row,ch*8),v);
      #define BL(w) __builtin_bit_cast(float,(w)<<16)
      #define BH(w) __builtin_bit_cast(float,(w)&0xffff0000u)
      float ss=(BL(v.x)*BL(v.x)+BH(v.x)*BH(v.x))+(BL(v.y)*BL(v.y)+BH(v.y)*BH(v.y))+(BL(v.z)*BL(v.z)+BH(v.z)*BH(v.z))+(BL(v.w)*BL(v.w)+BH(v.w)*BH(v.w));
      #undef BL
      #undef BH
      ss+=shx<1>(ss); ss+=shx<2>(ss); ss+=shx<4>(ss);
      if(ch==0)__hip_atomic_fetch_add(sqw+row,ss,__ATOMIC_RELAXED,__HIP_MEMORY_SCOPE_AGENT); } }
  asm volatile("s_waitcnt lgkmcnt(0)\n\ts_barrier":::"memory");
  #undef DMA_K
  #undef DMA_V
  #undef CMASK
  #undef CINIT
  #undef START
  #undef RESC
  #undef ROT
}
constexpr int ATTN_LDS_BYTES=LDS_BYTES;
struct AttnTensors { const bf16* Q; const bf16* K; const bf16* V; bf16* O; const float* kmean; float* rowsq; };
struct AttnUnit { int bh; int qb; };
__device__ constexpr unsigned char ATT_TAB[16][8]={{127,101,68,37,26,33,1,0},{119,93,60,36,23,49,7,48},{111,85,52,35,22,41,6,40},{103,77,47,122,90,21,5,32},{95,69,46,114,82,20,4,24},{87,61,45,106,74,19,3,16},{79,53,44,98,66,18,2,8},{71,124,108,91,58,121,25,120},
  {63,116,100,83,50,113,17,112},{126,70,123,75,42,105,15,104},{118,62,115,67,34,97,14,96},{110,55,107,59,31,89,13,88},{102,54,99,51,30,81,12,80},{94,125,92,43,29,73,11,72},{86,117,84,39,28,65,10,64},{78,109,76,38,27,57,9,56}};
struct StaticOrder {
  int vcu,grid;
  __device__ __forceinline__ explicit StaticOrder(int grid_,int vcu_):vcu(vcu_),grid(grid_){}
  __device__ __forceinline__ bool next(int i,AttnUnit&u)const{ const int n=i*grid+vcu; if(n>=BATCH*NHEAD*NQB)return false; const int sid=n%(BATCH*NHEAD),code=ATT_TAB[sid&15][n/(BATCH*NHEAD)]; u.bh=(sid>>4)*NHEAD+(code>>3); u.qb=code&7; return true; }
  __device__ __forceinline__ void a_ready(const AttnUnit&)const{}
  __device__ __forceinline__ void done(const AttnUnit&)const{}
};
template<class Sched,int THRL=8> __device__ __forceinline__ void attn_phase(char*lds,const AttnTensors&T,const Sched&S){
  AttnUnit u,un; bf16x8 qn[4]; qn[0]=qn[1]=qn[2]=qn[3]=bf16x8{}; bool pref=false; bool has=S.next(0,u);
  for(int i=0;has;++i){ const bool hn=S.next(i+1,un); S.a_ready(u);
    attn_unit<THRL>(u.bh/NHEAD,u.bh%NHEAD,u.qb,T.Q,T.K,T.V,T.O,T.kmean,T.rowsq,lds,pref,hn,un.bh/NHEAD,un.bh%NHEAD,un.qb,qn); S.done(u); u=un; has=hn; pref=hn; }
}
#undef SBAR
#undef WAIT_BAR
}
#define GAS __attribute__((address_space(1)))
#define LAS __attribute__((address_space(3)))
typedef unsigned short bf16;
typedef unsigned v4u __attribute__((ext_vector_type(4)));
typedef float f32x4 __attribute__((ext_vector_type(4)));
typedef short bf16x8 __attribute__((ext_vector_type(8)));
typedef GAS unsigned gu32;
typedef GAS unsigned long long gu64;
#define RLX_AGENT __ATOMIC_RELAXED, __HIP_MEMORY_SCOPE_AGENT
#define LDS_WAIT() asm volatile("s_waitcnt lgkmcnt(0)" ::: "memory")
#define VM_WAIT() asm volatile("s_waitcnt vmcnt(0)" ::: "memory")
__device__ __forceinline__ unsigned long long rt() { return __builtin_amdgcn_s_memrealtime(); }
__device__ __forceinline__ unsigned f2bf(float f) { unsigned u = __builtin_bit_cast(unsigned, f); return (u + 0x7fffu + ((u >> 16) & 1u)) >> 16; }
__device__ __forceinline__ unsigned pk2(float lo, float hi) { return f2bf(lo) | (f2bf(hi) << 16); }

#define XB_TMO      128
#define XB_XCNT(j)  (256  + 64 * (j))
#define XB_XSUB(j)  (1280 + 64 * (j))
#define XB_XGEN(j)  (2304 + 64 * (j))
#define XB_TOP      3328
#define XB_TOPGEN   3392
#define XCD_BAR_WORDS 3456
#define XB_SPIN_CAP (1u << 18)

__device__ __forceinline__ unsigned xb_ld(unsigned* p)              { return __hip_atomic_load(p, __ATOMIC_RELAXED, __HIP_MEMORY_SCOPE_AGENT); }
__device__ __forceinline__ unsigned xb_add(unsigned* p, unsigned v) { return __hip_atomic_fetch_add(p, v, __ATOMIC_RELAXED, __HIP_MEMORY_SCOPE_AGENT); }
__device__ __forceinline__ unsigned xb_xcc_id() { return (unsigned)__builtin_amdgcn_s_getreg((3 << 11) | 20) & 0xFu; }
#define XB_SPIN(cond, bar) do { unsigned _sp = 0; while (cond) { __builtin_amdgcn_s_sleep(1); \
    if ((++_sp & 255u) == 0u) { if (xb_ld(&(bar)[XB_TMO])) break; if (_sp > XB_SPIN_CAP) { atomicAdd(&(bar)[XB_TMO], 1u); break; } } } } while (0)

struct XcdBarrier {
    unsigned* bar; unsigned x;
    volatile LAS unsigned* st;
};

__device__ __forceinline__ XcdBarrier xcd_barrier_post(unsigned* bar, volatile LAS unsigned* st) {
    XcdBarrier b; b.bar = bar; b.x = xb_xcc_id(); b.st = st;
    if (threadIdx.x == 0) (void)xb_add(&bar[XB_XCNT(b.x)], 1u);
    return b;
}
__device__ __forceinline__ void xcd_barrier_complete(unsigned* bar, unsigned x, unsigned& nloc, unsigned& nx) {
    const unsigned G = gridDim.x * gridDim.y * gridDim.z;
    unsigned sum, cnt, mine, sp = 0u;
    for (;;) {
        sum = 0u; cnt = 0u; mine = 0u;
#pragma unroll
        for (unsigned j = 0; j < 16; ++j) { const unsigned c = xb_ld(&bar[XB_XCNT(j)]); sum += c; cnt += (c > 0u) ? 1u : 0u; mine = (j == x) ? c : mine; }
        if (sum == G) break;
        __builtin_amdgcn_s_sleep(1);
        if ((++sp & 255u) == 0u) { if (xb_ld(&bar[XB_TMO])) break; if (sp > XB_SPIN_CAP) { atomicAdd(&bar[XB_TMO], 1u); break; } }
    }
    nloc = mine > 0u ? mine : 1u; nx = cnt > 0u ? cnt : 1u;
}

__device__ __forceinline__ void xcd_barrier(const XcdBarrier& b) {
    asm volatile("s_waitcnt vmcnt(0)" ::: "memory");
    __syncthreads();
    if (threadIdx.x == 0) {
        unsigned* bar = b.bar;
        __builtin_amdgcn_s_waitcnt(0);
        unsigned nloc = b.st[0], nx = b.st[1];
        if (nloc == 0u) { xcd_barrier_complete(bar, b.x, nloc, nx); b.st[0] = nloc; b.st[1] = nx; }
        const unsigned old = xb_add(&bar[XB_XSUB(b.x)], 1u);
        const unsigned gen = old / nloc;
        if (old + 1u == (gen + 1u) * nloc) {
            __builtin_amdgcn_fence(__ATOMIC_RELEASE, "agent");
            asm volatile("s_waitcnt vmcnt(0)" ::: "memory");
            const unsigned og = xb_add(&bar[XB_TOP], 1u);
            const unsigned tg = og / nx;
            if (og + 1u == (tg + 1u) * nx) xb_add(&bar[XB_TOPGEN], 1u);
            else XB_SPIN(xb_ld(&bar[XB_TOPGEN]) == tg, bar);
            __builtin_amdgcn_fence(__ATOMIC_ACQUIRE, "agent");
            xb_add(&bar[XB_XGEN(b.x)], 1u);
            asm volatile("s_waitcnt vmcnt(0)" ::: "memory");
        } else {
            XB_SPIN(xb_ld(&bar[XB_XGEN(b.x)]) == gen, bar);
            __builtin_amdgcn_fence(__ATOMIC_ACQUIRE, "agent");
            asm volatile("s_waitcnt vmcnt(0)" ::: "memory");
        }
    }
    __syncthreads();
}

__device__ __forceinline__ void group_barrier(unsigned* ctr, unsigned target, unsigned* bar) {
    asm volatile("s_waitcnt vmcnt(0)" ::: "memory");
    __syncthreads();
    if (threadIdx.x == 0) {
        __builtin_amdgcn_s_waitcnt(0);
        __builtin_amdgcn_fence(__ATOMIC_RELEASE, "agent");
        asm volatile("s_waitcnt vmcnt(0)" ::: "memory");
        (void)xb_add(ctr, 1u);
        XB_SPIN(xb_ld(ctr) < target, bar);
        __builtin_amdgcn_fence(__ATOMIC_ACQUIRE, "agent");
        asm volatile("s_waitcnt vmcnt(0)" ::: "memory");
    }
    __syncthreads();
}

constexpr int NWAVES = 8;
constexpr size_t MiB = 1u << 20;
constexpr size_t WS_CTL = 0, CTL_ZERO_BYTES = 2 * MiB;
constexpr size_t WS_KMEAN = 1 * MiB;
constexpr size_t WS_ROWSQ = 1 * MiB + 512 * 1024;
constexpr size_t WS_WIN = 2 * MiB, WS_WGLU = 19 * MiB, WS_WOUT = 22 * MiB, WS_W1 = 31 * MiB, WS_W2 = 65 * MiB;
constexpr size_t WS_W3 = 98 * MiB, WS_F = 110 * MiB, WS_AT = 118 * MiB;
constexpr size_t WS_X1B = 120 * MiB;
constexpr size_t WS_HID = 256 * MiB;
constexpr size_t WS_XB = 772 * MiB;
constexpr size_t WS_Q = 388 * MiB, WS_K = 452 * MiB, WS_V = 516 * MiB;
constexpr size_t WS_X3 = 580 * MiB;
constexpr size_t WS_L = 676 * MiB;
constexpr size_t WS_ACT = 900 * MiB, WS_END = 964 * MiB;
static_assert(WS_WIN + (size_t)NPROJ * LDM * 2 <= WS_WGLU && WS_WGLU + (size_t)SW * LDS1 * 2 <= WS_WOUT && WS_WOUT + (size_t)DM * LDM * 2 <= WS_W1 && WS_W1 + (size_t)DFF * LDM * 2 <= WS_W2 && WS_W2 + (size_t)DM * LDF * 2 <= WS_W3, "weight map");
static_assert(WS_X1B + (size_t)MTOK * LDM * 2 <= WS_HID && WS_HID + (size_t)MTOK * DM * 2 <= WS_Q && WS_L + (size_t)SG * BATCH * NCH * 128 * 4 <= WS_XB && WS_HID + (size_t)MTOK * LDF * 2 <= WS_XB && WS_XB + (size_t)MTOK * DM * 2 <= WS_ACT && WS_ACT + (size_t)MTOK * SW * 2 <= WS_END, "activation map");
constexpr int CW_TMO = 0, CW_CODE = 1, CW_BAR = 4096, CW_TS = 16384, CW_XQ = 8192, CW_GB = 12288;

constexpr int RING_OFF = 0, RING_BYTES = 131072;
constexpr int LDSCTL_OFF = RING_BYTES, MISC_OFF = LDSCTL_OFF + 320;
constexpr int LDS_BYTES = 147456;

struct Args { const float* in[21]; float* out; unsigned char* ws; };
struct Frame {
    LAS unsigned char* lds;
    volatile LAS unsigned* MISC;
    gu32* ctl;
    int tid, lane, wave, vcu, G;
};
__device__ __forceinline__ float wave_sum(float v) {
    v += shx<1>(v); v += shx<2>(v); v += shx<4>(v); v += shx<8>(v); v += shx<16>(v);
    return xsum32(v);
}
__device__ __forceinline__ float bflo(unsigned w) { return __builtin_bit_cast(float, w << 16); }
__device__ __forceinline__ float bfhi(unsigned w) { return __builtin_bit_cast(float, w & 0xffff0000u); }
__device__ __forceinline__ float gelu_tanh(float y) {
    const float z = y * (1.0f + 0.044715f * y * y) * (-2.0f * 0.7978845608028654f * LOG2E);
    return y * __builtin_amdgcn_rcpf(1.0f + __builtin_amdgcn_exp2f(z));
}

__device__ __forceinline__ void ssm_precompute(Frame& F, const Args& A, int g, bf16* W3, bf16* FM, float* AT) {
    LAS float* pwr = (LAS float*)(F.lds + RING_OFF);
    LAS float* pwi = pwr + 17 * 64;
    LAS float* bbr = pwi + 17 * 64;
    LAS float* bbi = bbr + 64 * 16;
    LAS float* ccr = bbi + 64 * 16;
    LAS float* cci = ccr + 16 * 64;
    LAS float* ktab = cci + 16 * 64;
    const int tid = F.tid;
    if (tid < 64) {
        const int p = tid;
        const float dt = expf(A.in[8][g]);
        const float lr = A.in[6][g * SP + p], li = A.in[7][g * SP + p];
        const float mag = expf(lr * dt), a_re = mag * cosf(li * dt), a_im = mag * sinf(li * dt);
        const float den = lr * lr + li * li, nr = a_re - 1.0f;
        const float f_re = (nr * lr + a_im * li) / den, f_im = (a_im * lr - nr * li) / den;
        float pr = 1.0f, pi = 0.0f;
        for (int t = 0; t <= 16; ++t) { pwr[t * 64 + p] = pr; pwi[t * 64 + p] = pi; const float nr2 = pr * a_re - pi * a_im, ni2 = pr * a_im + pi * a_re; pr = nr2; pi = ni2; }
        AT[(g * SP + p) * 2] = pwr[16 * 64 + p]; AT[(g * SP + p) * 2 + 1] = pwi[16 * 64 + p];
        for (int h = 0; h < 16; ++h) { const float br = A.in[9][(size_t)(g * SP + p) * SC + h], bi = A.in[10][(size_t)(g * SP + p) * SC + h];
            bbr[p * 16 + h] = f_re * br - f_im * bi; bbi[p * 16 + h] = f_re * bi + f_im * br; }
    }
    for (int i = tid; i < 16 * 64; i += NWAVES * 64) { ccr[i] = A.in[11][(size_t)g * 16 * 64 + i]; cci[i] = A.in[12][(size_t)g * 16 * 64 + i]; }
    __syncthreads();
    {
        const int h = (tid >> 4) & 15, h2 = tid & 15, t0 = tid >> 8;
        float s[8];
#pragma unroll
        for (int k = 0; k < 8; ++k) s[k] = 0.f;
        for (int p = 0; p < 64; ++p) { const float cr = ccr[h * 64 + p], ci = cci[h * 64 + p], br = bbr[p * 16 + h2], bi = bbi[p * 16 + h2];
            const float U = cr * br - ci * bi, V = cr * bi + ci * br;
#pragma unroll
            for (int k = 0; k < 8; ++k) s[k] += pwr[(2 * k + t0) * 64 + p] * U - pwi[(2 * k + t0) * 64 + p] * V; }
        if (t0 == 0 && h == h2) s[0] += A.in[13][g * SC + h];
#pragma unroll
        for (int k = 0; k < 8; ++k) ktab[(2 * k + t0) * 256 + h * 16 + h2] = s[k];
    }
    __syncthreads();
    bf16* w3 = W3 + (size_t)g * 256 * X3LD;
    for (int idx = tid; idx < 256 * (X3LD / 8); idx += NWAVES * 64) {
        const int row = idx / (X3LD / 8), c8 = (idx % (X3LD / 8)) * 8, i = row >> 4, h = row & 15;
        float v[8];
        if (c8 < 256) { const int j = c8 >> 4, h0 = c8 & 15;
#pragma unroll
            for (int e = 0; e < 8; ++e) v[e] = (j <= i) ? ktab[((i - j) * 16 + h) * 16 + h0 + e] : 0.f;
        } else {
#pragma unroll
            for (int e = 0; e < 8; ++e) { const int ci = c8 - 256 + e, ri = ci >> 6, p = ci & 63; const float ar = pwr[(i + 1) * 64 + p], ai = pwi[(i + 1) * 64 + p], cr = ccr[h * 64 + p], cim = cci[h * 64 + p];
                v[e] = (ri == 0) ? (cr * ar - cim * ai) : -(cr * ai + cim * ar); }
        }
        v4u o; o.x = pk2(v[0], v[1]); o.y = pk2(v[2], v[3]); o.z = pk2(v[4], v[5]); o.w = pk2(v[6], v[7]);
        *(GAS v4u*)(w3 + (size_t)row * X3LD + c8) = o;
    }
    bf16* fm = FM + (size_t)g * 256 * 256;
    for (int idx = tid; idx < 256 * 32; idx += NWAVES * 64) {
        const int row = idx >> 5, c8 = (idx & 31) * 8;
        float v[8];
        if (row < 128) { const int ri = row >> 6, p = row & 63, j = c8 >> 4, h0 = c8 & 15; const float ar = pwr[(15 - j) * 64 + p], ai = pwi[(15 - j) * 64 + p];
#pragma unroll
            for (int e = 0; e < 8; ++e) { const float br = bbr[p * 16 + h0 + e], bi = bbi[p * 16 + h0 + e]; v[e] = (ri == 0) ? (ar * br - ai * bi) : (ar * bi + ai * br); }
        } else {
#pragma unroll
            for (int e = 0; e < 8; ++e) v[e] = 0.f;
        }
        v4u o; o.x = pk2(v[0], v[1]); o.y = pk2(v[2], v[3]); o.z = pk2(v[4], v[5]); o.w = pk2(v[6], v[7]);
        *(GAS v4u*)(fm + (size_t)row * 256 + c8) = o;
    }
    __syncthreads();
}
__device__ __forceinline__ void ssm_carry(Frame& F, const float* L, const float* AT, bf16* X3) {
    if (F.tid >= 256) return;
    for (int gid = F.vcu * 256 + F.tid; gid < SG * BATCH * SP; gid += F.G * 256) {
    const int p = gid & 63, b = (gid >> 6) & 15, g = gid >> 10;
    const float ar = AT[(g * SP + p) * 2], ai = AT[(g * SP + p) * 2 + 1];
    const size_t row0 = (size_t)g * (BATCH * NCH) + (size_t)b * NCH;
    const GAS float* lp = (const GAS float*)L + row0 * (2 * SP) + p;
    GAS bf16* xp = (GAS bf16*)X3 + row0 * X3LD + 256 + p;
    float sr = 0.f, si = 0.f;
    for (int c0 = 0; c0 < NCH; c0 += 16) {
        float lr[16], li[16];
#pragma unroll
        for (int k = 0; k < 16; ++k) { lr[k] = lp[(size_t)(c0 + k) * (2 * SP)]; li[k] = lp[(size_t)(c0 + k) * (2 * SP) + SP]; }
#pragma unroll
        for (int k = 0; k < 16; ++k) { xp[(size_t)(c0 + k) * X3LD] = (bf16)f2bf(sr); xp[(size_t)(c0 + k) * X3LD + SP] = (bf16)f2bf(si);
            const float nr = ar * sr - ai * si + lr[k], ni = ar * si + ai * sr + li[k]; sr = nr; si = ni; }
    }
    }
}

template <int GAIN, int PERMQ, bool BLK = false>
__device__ __forceinline__ void p0_transpose_item(const float* W, const float* gk, const float* gk2, int ksplit, int K, int N, bf16* WT, int ldt, LAS float* scr, int item, int lane) {
    const int nblk = N / 32, kb = item / nblk, nb = item % nblk, k0 = 64 * kb, n0 = 32 * nb;
#pragma unroll 8
    for (int i = 0; i < 32; ++i) { const int kk = 2 * i + (lane >> 5), k = k0 + kk; float w = W[(size_t)k * N + n0 + (lane & 31)];
        if constexpr (GAIN == 1) w *= gk[k];
        if constexpr (GAIN == 2) { const float* gp = (k < ksplit) ? gk + k : gk2 + (k - ksplit); w *= *gp; }
        scr[kk * 33 + (lane & 31)] = w; }
    LDS_WAIT(); asm volatile("" ::: "memory");
    int d0 = n0;
    if (PERMQ == 2 || (PERMQ == 1 && nb < 64)) { const int w8 = nb & 7; d0 = (nb & ~7) * 32 + 32 * (4 * (w8 & 1) + (w8 >> 1)); }
    const int c = lane & 7;
#pragma unroll
    for (int j = 0; j < 4; ++j) { const int n = (lane >> 3) + 8 * j; const LAS float* s = scr + (8 * c) * 33 + n;
        v4u o; o.x = pk2(s[0 * 33], s[1 * 33]); o.y = pk2(s[2 * 33], s[3 * 33]); o.z = pk2(s[4 * 33], s[5 * 33]); o.w = pk2(s[6 * 33], s[7 * 33]);
        if constexpr (BLK) { const int P = d0 + n; *(GAS v4u*)(WT + ((size_t)(P >> 8) * (K / 64) + kb) * 16384 + pg8::img_in((P & 255 & ~31) + pg8::inv_perm32(P & 31), 8 * c)) = o; }
        else *(GAS v4u*)(WT + (size_t)(d0 + n) * ldt + k0 + 8 * c) = o; }
    LDS_WAIT(); asm volatile("" ::: "memory");
}
__device__ __forceinline__ void rms_row_to_bf16(const float* xrow, bf16* orow, int rit, int lane) {
    const GAS f32x4* xr = (const GAS f32x4*)xrow + lane;
    f32x4 v[8]; float s = 0.f;
#pragma unroll
    for (int j = 0; j < 8; ++j) { v[j] = xr[64 * j]; s += (v[j].x * v[j].x + v[j].y * v[j].y) + (v[j].z * v[j].z + v[j].w * v[j].w); }
    const float r = rsqrtf(wave_sum(s) * (1.0f / (float)DM) + EPS);
    GAS bf16* ob = (GAS bf16*)orow + (size_t)(lane >> 4) * 16384 + pg8::img_in(rit, 4 * (lane & 15));
#pragma unroll
    for (int j = 0; j < 8; ++j) *(GAS unsigned long long*)(ob + (size_t)j * 4 * 16384) = (unsigned long long)pk2(v[j].x * r, v[j].y * r) | ((unsigned long long)pk2(v[j].z * r, v[j].w * r) << 32);
}
__device__ __forceinline__ void p0_prologue(Frame& F, const Args& A) {
    unsigned char* ws = A.ws;
    LAS float* scr = (LAS float*)(F.lds + RING_OFF + F.wave * 16384);
    const int gw = F.vcu * NWAVES + F.wave, NGW = F.G * NWAVES;
    for (int g = F.vcu; g < SG; g += F.G) ssm_precompute(F, A, g, (bf16*)(ws + WS_W3), (bf16*)(ws + WS_F), (float*)(ws + WS_AT));
    constexpr int I_IN = (DM / 64) * (NPROJ / 32), I_GLU = (SW / 64) * (SW / 32), I_OUT = (DM / 64) * (DM / 32), I_1 = (DM / 64) * (DFF / 32), I_2 = (DFF / 64) * (DM / 32);
    constexpr int NITEMS = I_IN + I_GLU + I_OUT + I_1 + I_2;
    for (int it = gw; it < NITEMS; it += NGW) {
        int r = it;
        if (r < I_IN) { p0_transpose_item<1, 1, true>(A.in[2], A.in[1], A.in[1], DM, DM, NPROJ, (bf16*)(ws + WS_WIN), 64, scr, r, F.lane); continue; } r -= I_IN;
        if (r < I_GLU) { p0_transpose_item<0, 0, 1>(A.in[14], A.in[14], A.in[14], SW, SW, SW, (bf16*)(ws + WS_WGLU), 64, scr, r, F.lane); continue; } r -= I_GLU;
        if (r < I_OUT) { p0_transpose_item<2, 0, true>(A.in[17], A.in[5], A.in[16], AW, DM, DM, (bf16*)(ws + WS_WOUT), 64, scr, r, F.lane); continue; } r -= I_OUT;
        if (r < I_1) { p0_transpose_item<1, 2, true>(A.in[19], A.in[18], A.in[18], DM, DM, DFF, (bf16*)(ws + WS_W1), 64, scr, r, F.lane); continue; } r -= I_1;
        p0_transpose_item<0, 0, true>(A.in[20], A.in[20], A.in[20], DFF, DFF, DM, (bf16*)(ws + WS_W2), 64, scr, r, F.lane);
    }
    __syncthreads();
    {   int it2 = 0; const int lane = F.lane;
        f32x4 v[2][8];
#define P0_LOADX(g_) do { _Pragma("unroll") for (int rr2 = 0; rr2 < 2; ++rr2) { const GAS f32x4* xr = (const GAS f32x4*)(A.in[0] + (size_t)((g_) * 16 + 2 * F.wave + rr2) * DM) + lane; \
            _Pragma("unroll") for (int j = 0; j < 8; ++j) v[rr2][j] = xr[64 * j]; } } while (0)
        if (F.vcu < MTOK / 16) P0_LOADX(F.vcu);
        for (int grp = F.vcu; grp < MTOK / 16; ++it2) {
            LAS unsigned char* buf = F.lds + RING_OFF + (it2 & 1) * 65536;
            if (F.tid == 0) F.MISC[16 + (it2 & 1)] = (unsigned)F.G + __hip_atomic_fetch_add(F.ctl + CW_XQ, 1u, RLX_AGENT);
#pragma unroll
            for (int rr2 = 0; rr2 < 2; ++rr2) {
                const int r = 2 * F.wave + rr2;
                float sq = 0.f;
#pragma unroll
                for (int j = 0; j < 8; ++j) sq += (v[rr2][j].x * v[rr2][j].x + v[rr2][j].y * v[rr2][j].y) + (v[rr2][j].z * v[rr2][j].z + v[rr2][j].w * v[rr2][j].w);
                const float rn = rsqrtf(wave_sum(sq) * (1.0f / (float)DM) + EPS);
                const int c = 4 * (lane & 15), inoff = (c >> 5) * 1024 + ((r * 64 + (c & 31) * 2) ^ (((r >> 3) & 1) << 5));
#pragma unroll
                for (int j = 0; j < 8; ++j) *(LAS unsigned long long*)(buf + (4 * j + (lane >> 4)) * 2048 + inoff) = (unsigned long long)pk2(v[rr2][j].x * rn, v[rr2][j].y * rn) | ((unsigned long long)pk2(v[rr2][j].z * rn, v[rr2][j].w * rn) << 32);
            }
            LDS_WAIT(); __syncthreads();
            const int nxt = (int)F.MISC[16 + (it2 & 1)];
            if (nxt < MTOK / 16) P0_LOADX(nxt);
            {   const int q = grp & 15;
                GAS unsigned char* dst = (GAS unsigned char*)(ws + WS_XB) + (size_t)(grp >> 4) * (DM / 64) * 32768 + (q >> 3) * 16384 + (q & 7) * 2048;
#pragma unroll
                for (int k = 0; k < 8; ++k) { const int sub = F.wave + 8 * k, kt = sub >> 1, cs = sub & 1;
                    const v4u w = *(const LAS v4u*)(buf + sub * 1024 + lane * 16);
                    *(GAS v4u*)(dst + (size_t)kt * 32768 + cs * 1024 + lane * 16) = w; }
            }
            grp = nxt;
        }
#undef P0_LOADX
        __syncthreads();
    }
}

__global__ void __launch_bounds__(NWAVES * 64, 2) hymba_fwd(Args args) {
    extern __shared__ __attribute__((aligned(16))) unsigned char lds[];
    Frame F;
    F.lds = (LAS unsigned char*)lds;
    F.MISC = (volatile LAS unsigned*)(F.lds + MISC_OFF);
    F.tid = threadIdx.x; F.lane = F.tid & 63; F.wave = __builtin_amdgcn_readfirstlane(F.tid >> 6);
    F.G = gridDim.x; { const int bx = blockIdx.x; F.vcu = (F.G % 8 == 0) ? (bx % 8) * (F.G / 8) + bx / 8 : bx; }
    unsigned char* ws = args.ws;
    F.ctl = (gu32*)(ws + WS_CTL);
    for (int u = F.tid; u < (LDS_BYTES - LDSCTL_OFF) / 4; u += NWAVES * 64) ((LAS unsigned*)(F.lds + LDSCTL_OFF))[u] = 0u;
    __syncthreads();
    XcdBarrier bar = xcd_barrier_post((unsigned*)(F.ctl + CW_BAR), F.MISC + 8);
#define GRID_BAR(k) xcd_barrier(bar)
#define GROUP_BAR(n) do { if ((F.G & 7) == 0) group_barrier((unsigned*)(F.ctl + CW_GB) + 64 * ((int)blockIdx.x & 7), (unsigned)(n) * (unsigned)(F.G >> 3), (unsigned*)(F.ctl + CW_BAR)); else xcd_barrier(bar); } while (0)

    bf16* const XB = (bf16*)(ws + WS_XB); bf16* const QB = (bf16*)(ws + WS_Q); bf16* const KB = (bf16*)(ws + WS_K); bf16* const VB = (bf16*)(ws + WS_V);
    bf16* const X3 = (bf16*)(ws + WS_X3); bf16* const ACT = (bf16*)(ws + WS_ACT);
    bf16* const X1B = (bf16*)(ws + WS_X1B); bf16* const HID = (bf16*)(ws + WS_HID);
    float* const LBUF = (float*)(ws + WS_L);
    float* const KMEAN = (float*)(ws + WS_KMEAN); float* const ROWSQ = (float*)(ws + WS_ROWSQ); float* const ROWSQA = ROWSQ + MTOK; float* const ROWSQS = ROWSQ + 2 * MTOK;

    p0_prologue(F, args);
    GRID_BAR(0);
    {   pg8::Gemm g{XB, (const bf16*)(ws + WS_WIN), MTOK, NPROJ, DM, 64, 64, true, true}; pg8::StaticOrder S; S.init(MTOK, NPROJ, F.G, (int)blockIdx.x);
        pg8::EpiProj E{QB, KB, VB, X3, KMEAN, args.in[3], args.in[4]};
        pg8::gemm_phase<pg8::EpiProj, pg8::StaticOrder, true, true>(F.lds + RING_OFF, g, S, E); }
    GRID_BAR(1);
    {   pg8::Gemm g{X3, (const bf16*)(ws + WS_F), SG * BATCH * NCH, 256, SCH * SC, X3LD, SCH * SC}; pg8::GroupOrder S{(int)F.G, F.vcu};
        pg8::EpiSsmL E{LBUF};
        pg8::gemm_phase<pg8::EpiSsmL, pg8::GroupOrder, true, true>(F.lds + RING_OFF, g, S, E); }
    GRID_BAR(2);
    ssm_carry(F, LBUF, (const float*)(ws + WS_AT), X3);
    {   const attn_body::AttnTensors AT{(const attn_body::bf16*)QB, (const attn_body::bf16*)KB, (const attn_body::bf16*)VB, (attn_body::bf16*)XB, KMEAN, ROWSQA};
        const attn_body::StaticOrder S((int)F.G, F.vcu);
        attn_body::attn_phase<attn_body::StaticOrder>((char*)lds + RING_OFF, AT, S); }
    GRID_BAR(3);
    {   pg8::Gemm g{X3, (const bf16*)(ws + WS_W3), SG * BATCH * NCH, 256, X3LD, X3LD, X3LD}; pg8::GroupOrder S{(int)F.G, F.vcu};
        pg8::EpiSsmY E{ACT};
        pg8::gemm_phase<pg8::EpiSsmY, pg8::GroupOrder, true, true>(F.lds + RING_OFF, g, S, E); }
    GRID_BAR(4);
    {   pg8::Gemm g{ACT, (const bf16*)(ws + WS_WGLU), MTOK, SW, SW, 64, 64, true, true}; pg8::StaticOrder S; S.init(MTOK, SW, F.G, (int)blockIdx.x);
        pg8::EpiGlu E{ACT, XB, args.in[15], ROWSQS};
        pg8::gemm_phase<pg8::EpiGlu, pg8::StaticOrder, true, true>(F.lds + RING_OFF, g, S, E); }
    GROUP_BAR(1);
    {   pg8::Gemm g{XB, (const bf16*)(ws + WS_WOUT), MTOK, DM, DM, 64, 64, true, true}; pg8::StaticOrder S; S.init(MTOK, DM, F.G, (int)blockIdx.x);
        pg8::EpiWout E{args.in[0], X1B, ROWSQ, ROWSQA, ROWSQS};
        pg8::gemm_phase<pg8::EpiWout, pg8::StaticOrder, true, true>(F.lds + RING_OFF, g, S, E); }
    GROUP_BAR(2);
    {   pg8::Gemm g{X1B, (const bf16*)(ws + WS_W1), MTOK, DFF, DM, 64, 64, true, true}; pg8::StaticOrder S; S.init(MTOK, DFF, F.G, (int)blockIdx.x);
        pg8::EpiFF1 E{HID, ROWSQ};
        pg8::gemm_phase<pg8::EpiFF1, pg8::StaticOrder, true, true>(F.lds + RING_OFF, g, S, E); }
    GROUP_BAR(3);
    {   pg8::Gemm g{HID, (const bf16*)(ws + WS_W2), MTOK, DM, DFF, 64, 64, true, true}; pg8::StaticOrder S; S.init(MTOK, DM, F.G, (int)blockIdx.x, 4);
        pg8::EpiFF2 E{args.out, X1B};
        pg8::gemm_phase<pg8::EpiFF2, pg8::StaticOrder, true, true>(F.lds + RING_OFF, g, S, E); }
#undef GRID_BAR
#undef GROUP_BAR
}

extern "C" void kernel_launch(void* const* d_in, const int* in_sizes, int n_in, void* d_out, int out_size, void* d_ws, size_t ws_size, hipStream_t stream) {
    static int grid = 0;
    if (grid == 0) {
        if (n_in != 21 || in_sizes[0] != MTOK * DM || out_size != MTOK * DM || ws_size < WS_END) { fprintf(stderr, "kernel_launch: unexpected shapes (n_in %d, in0 %d, out %d, ws %zu); nothing launched\n", n_in, n_in > 0 ? in_sizes[0] : -1, out_size, ws_size); grid = -1; return; }
        int dev = 0, cus = 0, per_cu = 0;
        if (hipGetDevice(&dev) != hipSuccess || hipDeviceGetAttribute(&cus, hipDeviceAttributeMultiprocessorCount, dev) != hipSuccess) { grid = -1; return; }
        if (hipFuncSetAttribute((const void*)hymba_fwd, hipFuncAttributeMaxDynamicSharedMemorySize, LDS_BYTES) != hipSuccess) { fprintf(stderr, "kernel_launch: hipFuncSetAttribute failed\n"); grid = -1; return; }
        if (hipOccupancyMaxActiveBlocksPerMultiprocessor(&per_cu, (const void*)hymba_fwd, NWAVES * 64, LDS_BYTES) != hipSuccess || per_cu < 1) { fprintf(stderr, "kernel_launch: occupancy query reports %d workgroups per CU\n", per_cu); (void)hipGetLastError(); grid = -1; return; }
        grid = cus;
    }
    if (grid < 0) return;
    if (hipMemsetAsync((char*)d_ws + WS_CTL, 0, CTL_ZERO_BYTES, stream) != hipSuccess) return;
    Args a{};
    for (int i = 0; i < 21; ++i) a.in[i] = (const float*)d_in[i];
    a.out = (float*)d_out; a.ws = (unsigned char*)d_ws;
    hipLaunchKernelGGL(hymba_fwd, dim3(grid), dim3(NWAVES * 64), LDS_BYTES, stream, a);
}
```

```cpp
#include <hip/hip_runtime.h>
#include <cstdio>
#include <cstdint>

constexpr int BATCH = 16, SEQ = 2048, DM = 2048, MTOK = BATCH * SEQ;
constexpr int AW = 1024, SW = 1024, NPROJ = 4096, NH = 16, HD = 64, DFF = 8192, NBLK = 8, MOBA = 256;
constexpr int SG = 64, SC = 16, SP = 64;
constexpr int SCH = 16, NCH = SEQ / SCH;
constexpr int X3LD = SCH * SC + 2 * SP;
constexpr int LDM = DM + 64, LDF = DFF + 64, LDS1 = SW + 64;
constexpr float EPS = 1e-6f;
constexpr float LOG2E = 1.4426950408889634f;
constexpr float QSCALE = 0.125f * LOG2E;

template <int MASK> __device__ __forceinline__ float shx(float v) { static_assert(MASK >= 1 && MASK <= 16, "shx"); return __builtin_bit_cast(float, __builtin_amdgcn_ds_swizzle(__builtin_bit_cast(int, v), (MASK << 10) | 0x1f)); }
__device__ __forceinline__ float xsum32(float v) { auto rr = __builtin_amdgcn_permlane32_swap(__float_as_uint(v), __float_as_uint(v), false, false); unsigned a = rr[0], b = rr[1]; asm volatile("" : "+v"(a), "+v"(b)); return __uint_as_float(a) + __uint_as_float(b); }
namespace pg8 {
#define PG8_LAS __attribute__((address_space(3)))
typedef unsigned short bf16_t;
typedef short bf16x8 __attribute__((ext_vector_type(8)));
typedef float f32x4 __attribute__((ext_vector_type(4)));
typedef unsigned u32x4 __attribute__((ext_vector_type(4)));
constexpr int BM = 256, BK = 64, HALF = 128, HTB = HALF * BK * 2  , STAGE_BYTES = 8 * HTB, NXCD = 8, WGM = 8;

__host__ __device__ __forceinline__ int lds_byte(int r, int c) { const int st = (r >> 4) * 2 + (c >> 5), rr = r & 15, cc = c & 31, ob = rr * 64 + cc * 2; return st * 1024 + (ob ^ (((ob >> 9) & 1) << 5)); }
__host__ __device__ __forceinline__ void stage_rc(int b, int& R, int& C) { const int st = b / 1024, sb = b % 1024, swz = sb ^ (((sb >> 9) & 1) << 5); R = (st >> 1) * 16 + swz / 64; C = (st & 1) * 32 + (swz % 64) / 2; }
__host__ __device__ __forceinline__ int perm32(int rho) { const int n = rho >> 4, i = rho & 15; return 8 * (i >> 2) + 4 * n + (i & 3); }

__host__ __device__ __forceinline__ int img_in(int r, int c) { return (r >> 7) * (HTB / 2) + lds_byte(r & 127, c) / 2; }
__host__ __device__ __forceinline__ int inv_perm32(int w) { return 16 * ((w >> 2) & 1) + 4 * (w >> 3) + (w & 3); }
struct Unit { int pm, pn; };
struct Gemm { const bf16_t* A; const bf16_t* Bt; int M, N, K, lda, ldb; bool blkA = false, blkB = false; };

struct StaticOrder {
    int nM, nN, nwg, G, c, wgm;
    __host__ __device__ void init(int M, int N, int G_, int c_, int wgm_ = WGM) { nM = M / BM; nN = N / BM; nwg = nM * nN; G = G_; c = c_; wgm = wgm_; }
    __host__ __device__ bool next(int i, Unit& u) const {
        const long L = (long)i * G + c; if (L >= nwg) return false;
        int wgid = (int)L; { const int q = nwg / NXCD, r = nwg % NXCD, xcd = wgid % NXCD, off = wgid / NXCD; wgid = (xcd < r ? xcd * (q + 1) : r * (q + 1) + (xcd - r) * q) + off; }
        const int nig = wgm * nN, gid = wgid / nig, fm = gid * wgm, gsz = (nM - fm) < wgm ? (nM - fm) : wgm;
        u.pm = fm + ((wgid % nig) % gsz); u.pn = (wgid % nig) / gsz; return true;
    }
    __device__ __forceinline__ void a_ready(const Unit&) const {}
    __device__ __forceinline__ void done(const Unit&) const {}
};

__device__ __forceinline__ unsigned cvt_pk_bf16(float lo, float hi) { unsigned r; asm volatile("v_cvt_pk_bf16_f32 %0, %1, %2" : "=v"(r) : "v"(lo), "v"(hi)); return r; }
typedef float f32x2 __attribute__((ext_vector_type(2)));
template <class Epi, class Sched, bool ALIGN_EPI = false, bool SP2 = false>
__device__ __forceinline__ void gemm_phase(PG8_LAS unsigned char* lds, const Gemm g, const Sched& S, const Epi& E) {
    int tid_ = threadIdx.x; asm volatile("" : "+v"(tid_));
    const int tid = tid_, wid = __builtin_amdgcn_readfirstlane(tid >> 6), lane = tid & 63, wr = wid >> 2, wc = wid & 3, fr = lane & 15, fq = lane >> 4;
    const int K = g.K, nt = K / BK;
    unsigned voffA[2], voffB[2];
#pragma unroll
    for (int i = 0; i < 2; ++i) { int R, C; stage_rc(tid * 16 + i * 8192, R, C); const int Rb = Epi::PERM ? ((R & ~31) + perm32(R & 31)) : R;
        voffA[i] = g.blkA ? (unsigned)(tid * 16 + i * 8192) : (unsigned)(R * g.lda + C) * 2u; voffB[i] = g.blkB ? (unsigned)(tid * 16 + i * 8192) : (unsigned)(Rb * g.ldb + C) * 2u; }
    const size_t kstepA = g.blkA ? (size_t)(BM * BK * 2) : (size_t)(BK * 2), kstepB = g.blkB ? (size_t)(BM * BK * 2) : (size_t)(BK * 2);
    const size_t hstepA = (size_t)HALF * g.lda * 2, hstepB = (size_t)HALF * g.ldb * 2;
    const size_t tstepA = g.blkA ? (size_t)nt * (BM * BK * 2) : 2 * hstepA, tstepB = g.blkB ? (size_t)nt * (BM * BK * 2) : 2 * hstepB;
    const unsigned ldsw = (unsigned)wid * 1024u;
    const int aoff = lds_byte(wr * 64 + fr, fq * 8), boff = lds_byte(wc * 32 + fr, fq * 8);
#define PG8_SA(b, h) (((b) * 2 + (h)) * HTB)
#define PG8_SB(b, h) ((4 + (b) * 2 + (h)) * HTB)
#define PG8_STAGE(bufoff, gbase, voff) do { _Pragma("unroll") for (int _i = 0; _i < 2; ++_i) \
        __builtin_amdgcn_global_load_lds((const unsigned*)((const char*)(gbase) + (voff)[_i]), (PG8_LAS unsigned*)(lds + (bufoff) + ldsw + _i * 8192), 16, 0, 0); } while (0)
#define PG8_LDA(dst, b, h) do { _Pragma("unroll") for (int m = 0; m < 4; ++m) _Pragma("unroll") for (int k = 0; k < 2; ++k) dst[m][k] = *(const PG8_LAS bf16x8*)(lds + PG8_SA(b, h) + aoff + m * 2048 + k * 1024); } while (0)
#define PG8_LDB(dst, b, h) do { _Pragma("unroll") for (int n = 0; n < 2; ++n) _Pragma("unroll") for (int k = 0; k < 2; ++k) dst[n][k] = *(const PG8_LAS bf16x8*)(lds + PG8_SB(b, h) + boff + n * 2048 + k * 1024); } while (0)
#define PG8_MMA(ai, bj, At, Bt) do { __builtin_amdgcn_s_setprio(1); _Pragma("unroll") for (int m = 0; m < 4; ++m) _Pragma("unroll") for (int n = 0; n < 2; ++n) _Pragma("unroll") for (int k = 0; k < 2; ++k) \
        acc[ai][bj][m][n] = __builtin_amdgcn_mfma_f32_16x16x32_bf16(Bt[n][k], At[m][k], acc[ai][bj][m][n], 0, 0, 0); __builtin_amdgcn_s_setprio(0); } while (0)
#define PG8_WAIT_V(n) asm volatile("s_waitcnt vmcnt(" #n ")" ::: "memory")
#define PG8_WAIT_L(n) asm volatile("s_waitcnt lgkmcnt(" #n ")" ::: "memory")
#define PG8_BAR __builtin_amdgcn_s_barrier()
#define PG8_SCHED __builtin_amdgcn_sched_barrier(0)
    Unit cur, nxt; int ui = 0;
    if (!S.next(0, cur)) return;
    f32x4 acc[2][2][4][2];
#pragma unroll
    for (int a = 0; a < 2; ++a)
#pragma unroll
        for (int b = 0; b < 2; ++b)
#pragma unroll
            for (int m = 0; m < 4; ++m)
#pragma unroll
                for (int n = 0; n < 2; ++n) acc[a][b][m][n] = (f32x4){0.f, 0.f, 0.f, 0.f};
    bf16x8 At[4][2], B0[2][2], B1[2][2];
    const char* cA = (const char*)g.A + (size_t)cur.pm * tstepA; const char* cB = (const char*)g.Bt + (size_t)cur.pn * tstepB;
    S.a_ready(cur);
    if constexpr (SP2) {
        PG8_STAGE(PG8_SB(0, 0), cB, voffB); PG8_STAGE(PG8_SB(0, 1), cB + hstepB, voffB); PG8_STAGE(PG8_SA(0, 0), cA, voffA); PG8_STAGE(PG8_SA(0, 1), cA + hstepA, voffA);
        if (wr == 1) PG8_BAR;
        PG8_WAIT_V(2); PG8_BAR;
        PG8_STAGE(PG8_SB(1, 0), cB + kstepB, voffB); PG8_STAGE(PG8_SA(1, 0), cA + kstepA, voffA); PG8_STAGE(PG8_SB(1, 1), cB + hstepB + kstepB, voffB);
        PG8_WAIT_V(6); PG8_BAR;
    } else {
        PG8_STAGE(PG8_SB(0, 0), cB, voffB); PG8_STAGE(PG8_SA(0, 0), cA, voffA); PG8_STAGE(PG8_SB(0, 1), cB + hstepB, voffB); PG8_STAGE(PG8_SA(0, 1), cA + hstepA, voffA);
        if (wr == 1) PG8_BAR;
        PG8_WAIT_V(4); PG8_BAR;
        PG8_STAGE(PG8_SB(1, 0), cB + kstepB, voffB); PG8_STAGE(PG8_SA(1, 0), cA + kstepA, voffA); PG8_STAGE(PG8_SB(1, 1), cB + hstepB + kstepB, voffB);
        PG8_WAIT_V(6); PG8_BAR;
    }
    for (;;) {
        const bool has_next = S.next(ui + 1, nxt);
        const char* nA = has_next ? (const char*)g.A + (size_t)nxt.pm * tstepA : cA; const char* nB = has_next ? (const char*)g.Bt + (size_t)nxt.pn * tstepB : cB;
        for (int t = 0; t < nt; t += 2) {
            if constexpr (Epi::MIDK) { if (t == nt / 2) E.mid(acc, cur, wr, wc, fr, fq); }
            const bool last = (t == nt - 2);
            const char* a1 = cA + (size_t)(t + 1) * kstepA;
            const char* a2 = last ? nA : cA + (size_t)(t + 2) * kstepA; const char* b2 = last ? nB : cB + (size_t)(t + 2) * kstepB;
            const char* a3 = a2 + kstepA; const char* b3 = b2 + kstepB;
            if (last && has_next) S.a_ready(nxt);
            if constexpr (SP2) {
            PG8_LDB(B0, 0, 0); PG8_LDB(B1, 0, 1); PG8_SCHED; PG8_LDA(At, 0, 0); PG8_STAGE(PG8_SA(1, 1), a1 + hstepA, voffA);
            PG8_WAIT_V(8); PG8_WAIT_L(0); PG8_BAR; PG8_MMA(0, 0, At, B0); PG8_MMA(0, 1, At, B1); PG8_BAR; PG8_SCHED;
            PG8_LDA(At, 0, 1); PG8_STAGE(PG8_SB(0, 0), b2, voffB); PG8_STAGE(PG8_SB(0, 1), b2 + hstepB, voffB); PG8_STAGE(PG8_SA(0, 0), a2, voffA);
            PG8_WAIT_V(8); PG8_WAIT_L(0); PG8_BAR; PG8_MMA(1, 0, At, B0); PG8_MMA(1, 1, At, B1); PG8_BAR; PG8_SCHED;
            PG8_LDB(B0, 1, 0); PG8_LDB(B1, 1, 1); PG8_SCHED; PG8_LDA(At, 1, 0); PG8_STAGE(PG8_SA(0, 1), a2 + hstepA, voffA);
            PG8_WAIT_V(8); PG8_WAIT_L(0); PG8_BAR; PG8_MMA(0, 0, At, B0); PG8_MMA(0, 1, At, B1); PG8_BAR; PG8_SCHED;
            PG8_LDA(At, 1, 1); PG8_STAGE(PG8_SB(1, 0), b3, voffB); PG8_STAGE(PG8_SB(1, 1), b3 + hstepB, voffB); PG8_STAGE(PG8_SA(1, 0), a3, voffA);
            PG8_WAIT_V(8); PG8_WAIT_L(0); PG8_BAR; PG8_MMA(1, 0, At, B0); PG8_MMA(1, 1, At, B1); PG8_BAR; PG8_SCHED;
            } else {
            PG8_LDB(B0, 0, 0); PG8_SCHED; PG8_LDA(At, 0, 0); PG8_STAGE(PG8_SA(1, 1), a1 + hstepA, voffA);
            PG8_WAIT_L(8); PG8_BAR; PG8_WAIT_L(0); PG8_MMA(0, 0, At, B0); PG8_BAR; PG8_SCHED;
            PG8_LDB(B1, 0, 1); PG8_STAGE(PG8_SB(0, 0), b2, voffB);
            PG8_BAR; PG8_WAIT_L(0); PG8_MMA(0, 1, At, B1); PG8_BAR;
            PG8_LDA(At, 0, 1); PG8_STAGE(PG8_SA(0, 0), a2, voffA);
            PG8_BAR; PG8_WAIT_L(0); PG8_MMA(1, 0, At, B0); PG8_BAR; PG8_SCHED;
            PG8_STAGE(PG8_SB(0, 1), b2 + hstepB, voffB);
            PG8_WAIT_V(6); PG8_BAR; PG8_MMA(1, 1, At, B1); PG8_BAR;
            PG8_LDB(B0, 1, 0); PG8_SCHED; PG8_LDA(At, 1, 0); PG8_STAGE(PG8_SA(0, 1), a2 + hstepA, voffA);
            PG8_WAIT_L(8); PG8_BAR; PG8_WAIT_L(0); PG8_MMA(0, 0, At, B0); PG8_BAR; PG8_SCHED;
            PG8_LDB(B1, 1, 1); PG8_STAGE(PG8_SB(1, 0), b3, voffB);
            PG8_BAR; PG8_WAIT_L(0); PG8_MMA(0, 1, At, B1); PG8_BAR;
            PG8_LDA(At, 1, 1); PG8_STAGE(PG8_SA(1, 0), a3, voffA);
            PG8_BAR; PG8_WAIT_L(0); PG8_MMA(1, 0, At, B0); PG8_BAR; PG8_SCHED;
            PG8_STAGE(PG8_SB(1, 1), b3 + hstepB, voffB);
            PG8_WAIT_V(6); PG8_BAR; PG8_MMA(1, 1, At, B1); PG8_BAR;
            }
        }
        if constexpr (ALIGN_EPI) { if (wr == 0) PG8_BAR; }
        if constexpr (!Epi::AFTER_DRAIN) { E(acc, cur, wr, wc, fr, fq); S.done(cur); }
        if (!has_next) break;
#pragma unroll
        for (int a = 0; a < 2; ++a)
#pragma unroll
            for (int b = 0; b < 2; ++b)
#pragma unroll
                for (int m = 0; m < 4; ++m)
#pragma unroll
                    for (int n = 0; n < 2; ++n) acc[a][b][m][n] = (f32x4){0.f, 0.f, 0.f, 0.f};
        cur = nxt; cA = nA; cB = nB; ++ui;
        if constexpr (ALIGN_EPI) { if (wr == 1) PG8_BAR; }
    }
    PG8_WAIT_V(0);
    if constexpr (!ALIGN_EPI) { if (wr == 0) PG8_BAR; }
    PG8_BAR;
    if constexpr (Epi::AFTER_DRAIN) { E.fused(acc, cur, wr, wc, fr, fq, lds, wid, lane); S.done(cur); }
#undef PG8_SA
#undef PG8_SB
#undef PG8_STAGE
#undef PG8_LDA
#undef PG8_LDB
#undef PG8_MMA
#undef PG8_WAIT_V
#undef PG8_WAIT_L
#undef PG8_BAR
#undef PG8_SCHED
}
__device__ __forceinline__ u32x4 pack8(const f32x4 v0, const f32x4 v1) { u32x4 w; w.x = cvt_pk_bf16(v0[0], v0[1]); w.y = cvt_pk_bf16(v0[2], v0[3]); w.z = cvt_pk_bf16(v1[0], v1[1]); w.w = cvt_pk_bf16(v1[2], v1[3]); return w; }
__device__ __forceinline__ float bflo(unsigned w) { return __builtin_bit_cast(float, w << 16); }
__device__ __forceinline__ float bfhi(unsigned w) { return __builtin_bit_cast(float, w & 0xffff0000u); }
__device__ __forceinline__ size_t blk_off(int pm, int nkt, int kt, int r, int c) { return ((size_t)pm * nkt + kt) * (BM * BK) + img_in(r, c); }
__device__ __forceinline__ float relu1(float x) { float r; asm("v_max_f32_e32 %0, 0, %1" : "=v"(r) : "v"(x)); return r; }
__device__ __forceinline__ float sq4(const f32x4 x) { return (x[0] * x[0] + x[1] * x[1]) + (x[2] * x[2] + x[3] * x[3]); }

struct EpiProj {
    static constexpr bool PERM = true, AFTER_DRAIN = false, MIDK = false;
    bf16_t* Q; bf16_t* Kb; bf16_t* V; bf16_t* X3; float* kmean; const float* qg; const float* kg;
    __device__ __forceinline__ void operator()(const f32x4 (&acc)[2][2][4][2], const Unit& u, int wr, int wc, int fr, int fq) const {
        const int pn = u.pn;
        const int row0 = u.pm * BM + wr * 64 + fr;
        if (pn < 8) {
            const bool isq = pn < 4;
            const float* gp = isq ? qg : kg; const float gs = isq ? QSCALE : 1.0f;
            f32x4 gv[2][2];
#pragma unroll
            for (int bj = 0; bj < 2; ++bj)
#pragma unroll
                for (int n = 0; n < 2; ++n) gv[bj][n] = *(const f32x4*)(gp + 32 * bj + 8 * fq + 4 * n) * gs;
            const int head = (pn & 3) * 4 + wc;
            bf16_t* base = (isq ? Q : Kb) + head * 64 + 8 * fq;
            f32x4 cs[2][2];
#pragma unroll
            for (int bj = 0; bj < 2; ++bj)
#pragma unroll
                for (int n = 0; n < 2; ++n) cs[bj][n] = (f32x4){0.f, 0.f, 0.f, 0.f};
#pragma unroll
            for (int ai = 0; ai < 2; ++ai)
#pragma unroll
                for (int m = 0; m < 4; ++m) {
                    float ss = 0.f;
#pragma unroll
                    for (int bj = 0; bj < 2; ++bj)
#pragma unroll
                        for (int n = 0; n < 2; ++n) ss += sq4(acc[ai][bj][m][n]);
                    ss += shx<16>(ss); ss = xsum32(ss);
                    const float rn = rsqrtf(ss * (1.0f / 64.0f) + EPS);
                    const int tq = (u.pm & 7) * BM + ai * HALF + wr * 64 + m * 16 + fr;
                    bf16_t* rowp = isq ? base + (size_t)(row0 + ai * HALF + m * 16) * AW
                                       : Kb + ((size_t)(((u.pm >> 3) * NH + head) * (SEQ / 64) + (tq >> 6)) * 8 + fq) * 512 + (tq & 63) * 8;
#pragma unroll
                    for (int bj = 0; bj < 2; ++bj) {
                        const f32x4 v0 = acc[ai][bj][m][0] * rn * gv[bj][0], v1 = acc[ai][bj][m][1] * rn * gv[bj][1];
                        cs[bj][0] += v0; cs[bj][1] += v1;
                        *(u32x4*)(rowp + (isq ? 32 * bj : 2048 * bj)) = pack8(v0, v1);
                    }
                }
            if (!isq) {
                float* km = kmean + ((size_t)((u.pm >> 3) * NH + head) * NBLK + (u.pm & 7)) * HD + 8 * fq;
#pragma unroll
                for (int bj = 0; bj < 2; ++bj)
#pragma unroll
                    for (int n = 0; n < 2; ++n)
#pragma unroll
                        for (int e = 0; e < 4; ++e) {
                            float v = cs[bj][n][e];
                            v += shx<1>(v); v += shx<2>(v); v += shx<4>(v); v += shx<8>(v);
                            if (fr == 0) __hip_atomic_fetch_add(km + 32 * bj + 4 * n + e, v, __ATOMIC_RELAXED, __HIP_MEMORY_SCOPE_AGENT);
                        }
            }
        } else if (pn < 12) {
#pragma unroll
            for (int ai = 0; ai < 2; ++ai)
#pragma unroll
                for (int m = 0; m < 4; ++m) {
                    const int tq = (u.pm & 7) * BM + ai * HALF + wr * 64 + m * 16 + fr;
#pragma unroll
                    for (int bj = 0; bj < 2; ++bj) { const int head = (pn - 8) * 4 + 2 * bj + (wc >> 1);
                        *(u32x4*)(V + ((size_t)(((u.pm >> 3) * NH + head) * (SEQ / 64) + (tq >> 6)) * 8 + (wc & 1) * 4 + ((tq >> 4) & 3)) * 512 + (tq & 15) * 32 + 8 * fq) = pack8(acc[ai][bj][m][0], acc[ai][bj][m][1]); }
                }
        } else {
            const int b = u.pm >> 3;
#pragma unroll
            for (int bj = 0; bj < 2; ++bj) {
                const int ch = (pn - 12) * 256 + bj * HALF + wc * 32 + 8 * fq, g = ch >> 4, h0 = ch & 15;
#pragma unroll
                for (int ai = 0; ai < 2; ++ai)
#pragma unroll
                    for (int m = 0; m < 4; ++m) {
                        const int c16 = (u.pm & 7) * 16 + ai * 8 + wr * 4 + m;
                        bf16_t* p = X3 + ((size_t)(g * (BATCH * NCH) + b * NCH + c16)) * X3LD + fr * SC + h0;
                        *(u32x4*)p = pack8(acc[ai][bj][m][0], acc[ai][bj][m][1]);
                    }
            }
        }
    }
};

struct EpiGlu {
    static constexpr bool PERM = true, AFTER_DRAIN = false, MIDK = false;
    const bf16_t* act; bf16_t* out; const float* bias; float* rowsq;
    __device__ __forceinline__ void operator()(const f32x4 (&acc)[2][2][4][2], const Unit& u, int wr, int wc, int fr, int fq) const {
        const int row0 = u.pm * BM + wr * 64 + fr, col0 = u.pn * BM + wc * 32 + 8 * fq;
        f32x4 bv[2][2]; u32x4 av[2][4][2];
#pragma unroll
        for (int bj = 0; bj < 2; ++bj)
#pragma unroll
            for (int n = 0; n < 2; ++n) bv[bj][n] = *(const f32x4*)(bias + col0 + bj * HALF + 4 * n);
#pragma unroll
        for (int ai = 0; ai < 2; ++ai)
#pragma unroll
            for (int m = 0; m < 4; ++m) { const size_t offa = blk_off(u.pm, SW / BK, 4 * u.pn + (wc >> 1), ai * HALF + wr * 64 + m * 16 + fr, 32 * (wc & 1) + 8 * fq);
#pragma unroll
                for (int bj = 0; bj < 2; ++bj) av[ai][m][bj] = *(const u32x4*)(act + offa + (size_t)bj * 2 * BM * BK); }
        asm volatile("" ::: "memory");
#pragma unroll
        for (int ai = 0; ai < 2; ++ai)
#pragma unroll
            for (int m = 0; m < 4; ++m) {
                const int row = row0 + ai * HALF + m * 16;
                const size_t off = blk_off(u.pm, DM / BK, AW / BK + 4 * u.pn + (wc >> 1), row - u.pm * BM, 32 * (wc & 1) + 8 * fq);
                float ss = 0.f;
#pragma unroll
                for (int bj = 0; bj < 2; ++bj) {
                    const u32x4 a = av[ai][m][bj];
                    const f32x4 a0 = (f32x4){bflo(a.x), bfhi(a.x), bflo(a.y), bfhi(a.y)}, a1 = (f32x4){bflo(a.z), bfhi(a.z), bflo(a.w), bfhi(a.w)};
                    const f32x4 g0 = (acc[ai][bj][m][0] + bv[bj][0]) * (-LOG2E), g1 = (acc[ai][bj][m][1] + bv[bj][1]) * (-LOG2E);
                    f32x4 o0, o1;
#pragma unroll
                    for (int e = 0; e < 4; ++e) { o0[e] = a0[e] * __builtin_amdgcn_rcpf(1.0f + __builtin_amdgcn_exp2f(g0[e])); o1[e] = a1[e] * __builtin_amdgcn_rcpf(1.0f + __builtin_amdgcn_exp2f(g1[e])); }
                    const u32x4 w = pack8(o0, o1);
                    *(u32x4*)(out + off + (size_t)bj * 2 * BM * BK) = w;
                    ss += (bflo(w.x) * bflo(w.x) + bfhi(w.x) * bfhi(w.x)) + (bflo(w.y) * bflo(w.y) + bfhi(w.y) * bfhi(w.y)) + (bflo(w.z) * bflo(w.z) + bfhi(w.z) * bfhi(w.z)) + (bflo(w.w) * bflo(w.w) + bfhi(w.w) * bfhi(w.w));
                }
                ss += shx<16>(ss); ss = xsum32(ss);
                if (fq == 0) __hip_atomic_fetch_add(rowsq + row, ss, __ATOMIC_RELAXED, __HIP_MEMORY_SCOPE_AGENT);
            }
    }
};

struct EpiWout {
    static constexpr bool PERM = true, AFTER_DRAIN = false, MIDK = true;
    const float* x; bf16_t* x1b; float* rowsq; const float* sqa; const float* sqs;
    __device__ __forceinline__ void mid(f32x4 (&acc)[2][2][4][2], const Unit& u, int wr, int wc, int fr, int fq) const {
        int row0 = u.pm * BM + wr * 64 + fr; asm volatile("" : "+v"(row0));
#pragma unroll
        for (int ai = 0; ai < 2; ++ai)
#pragma unroll
            for (int m = 0; m < 4; ++m) { const int row = row0 + ai * HALF + m * 16;
                const float f = rsqrtf(sqa[row] * (1.0f / (float)AW) + EPS) * sqrtf(sqs[row] * (1.0f / (float)SW) + EPS);
#pragma unroll
                for (int bj = 0; bj < 2; ++bj)
#pragma unroll
                    for (int n = 0; n < 2; ++n) acc[ai][bj][m][n] *= f; }
    }
    __device__ __forceinline__ void operator()(const f32x4 (&acc)[2][2][4][2], const Unit& u, int wr, int wc, int fr, int fq) const {
        const int row0 = u.pm * BM + wr * 64 + fr, col0 = u.pn * BM + wc * 32 + 8 * fq;
        float rs[2][4];
#pragma unroll
        for (int ai = 0; ai < 2; ++ai)
#pragma unroll
            for (int m = 0; m < 4; ++m) rs[ai][m] = rsqrtf(sqs[row0 + ai * HALF + m * 16] * (1.0f / (float)SW) + EPS);
#pragma unroll
        for (int ai = 0; ai < 2; ++ai) {
            f32x4 xv[4][2][2];
#pragma unroll
            for (int m = 0; m < 4; ++m) { const size_t off = (size_t)(row0 + ai * HALF + m * 16) * DM + col0;
#pragma unroll
                for (int bj = 0; bj < 2; ++bj) { xv[m][bj][0] = *(const f32x4*)(x + off + bj * HALF); xv[m][bj][1] = *(const f32x4*)(x + off + bj * HALF + 4); } }
            asm volatile("" ::: "memory");
#pragma unroll
            for (int m = 0; m < 4; ++m) {
                const int row = row0 + ai * HALF + m * 16; const size_t offb = blk_off(u.pm, DM / BK, 4 * u.pn + (wc >> 1), row - u.pm * BM, 32 * (wc & 1) + 8 * fq);
                float ss = 0.f;
#pragma unroll
                for (int bj = 0; bj < 2; ++bj) {
                    const f32x4 v0 = acc[ai][bj][m][0] * rs[ai][m] + xv[m][bj][0], v1 = acc[ai][bj][m][1] * rs[ai][m] + xv[m][bj][1];
                    *(u32x4*)(x1b + offb + (size_t)bj * 2 * BM * BK) = pack8(v0, v1);
                    ss += sq4(v0) + sq4(v1);
                }
                ss += shx<16>(ss); ss = xsum32(ss);
                if (fq == 0) __hip_atomic_fetch_add(rowsq + row, ss, __ATOMIC_RELAXED, __HIP_MEMORY_SCOPE_AGENT);
            }
            asm volatile("" ::: "memory");
        }
    }
};

struct EpiFF1 {
    static constexpr bool PERM = true, AFTER_DRAIN = false, MIDK = false;
    bf16_t* hid; const float* rowsq;
    __device__ __forceinline__ void operator()(const f32x4 (&acc)[2][2][4][2], const Unit& u, int wr, int wc, int fr, int fq) const {
        const int row0 = u.pm * BM + wr * 64 + fr;
        float r2[2][4];
#pragma unroll
        for (int ai = 0; ai < 2; ++ai)
#pragma unroll
            for (int m = 0; m < 4; ++m) r2[ai][m] = __builtin_amdgcn_rcpf(rowsq[row0 + ai * HALF + m * 16] * (1.0f / (float)DM) + EPS);
        asm volatile("" ::: "memory");
#pragma unroll
        for (int ai = 0; ai < 2; ++ai)
#pragma unroll
            for (int m = 0; m < 4; ++m) {
                bf16_t* rowp = hid + blk_off(u.pm, DFF / BK, 4 * u.pn + wc, ai * HALF + wr * 64 + m * 16 + fr, 8 * fq);
#pragma unroll
                for (int bj = 0; bj < 2; ++bj) {
                    f32x4 v0 = acc[ai][bj][m][0], v1 = acc[ai][bj][m][1];
#pragma unroll
                    for (int e = 0; e < 4; ++e) { v0[e] = relu1(v0[e]); v1[e] = relu1(v1[e]); }
                    v0 = (v0 * v0) * r2[ai][m]; v1 = (v1 * v1) * r2[ai][m];
                    *(u32x4*)(rowp + 512 * bj) = pack8(v0, v1);
                }
            }
    }
};

struct EpiFF2 {
    static constexpr bool PERM = true, AFTER_DRAIN = false, MIDK = false;
    float* out; const bf16_t* x1b;
    __device__ __forceinline__ void operator()(const f32x4 (&acc)[2][2][4][2], const Unit& u, int wr, int wc, int fr, int fq) const {
        const int row0 = u.pm * BM + wr * 64 + fr, col0 = u.pn * BM + wc * 32 + 8 * fq;
        u32x4 av[2][4][2];
#pragma unroll
        for (int ai = 0; ai < 2; ++ai)
#pragma unroll
            for (int m = 0; m < 4; ++m) { const bf16_t* xp = x1b + blk_off(u.pm, DM / BK, 4 * u.pn + (wc >> 1), ai * HALF + wr * 64 + m * 16 + fr, 32 * (wc & 1) + 8 * fq);
#pragma unroll
                for (int bj = 0; bj < 2; ++bj) av[ai][m][bj] = *(const u32x4*)(xp + (size_t)bj * 2 * BM * BK); }
        asm volatile("" ::: "memory");
#pragma unroll
        for (int ai = 0; ai < 2; ++ai)
#pragma unroll
            for (int m = 0; m < 4; ++m) {
                float* rowp = out + (size_t)(row0 + ai * HALF + m * 16) * DM + col0;
#pragma unroll
                for (int bj = 0; bj < 2; ++bj) { const u32x4 a = av[ai][m][bj];
                    *(f32x4*)(rowp + bj * HALF) = acc[ai][bj][m][0] + (f32x4){bflo(a.x), bfhi(a.x), bflo(a.y), bfhi(a.y)};
                    *(f32x4*)(rowp + bj * HALF + 4) = acc[ai][bj][m][1] + (f32x4){bflo(a.z), bfhi(a.z), bflo(a.w), bfhi(a.w)}; }
            }
    }
};

struct GroupOrder {
    int G, c;
    __device__ __forceinline__ bool next(int i, Unit& u) const { const int n = i * G + c; if (n >= SG * 8) return false; u.pm = n; u.pn = n >> 3; return true; }
    __device__ __forceinline__ void a_ready(const Unit&) const {}
    __device__ __forceinline__ void done(const Unit&) const {}
};
struct EpiSsmL {
    static constexpr bool PERM = false, AFTER_DRAIN = false, MIDK = false;
    float* L;
    __device__ __forceinline__ void operator()(const f32x4 (&acc)[2][2][4][2], const Unit& u, int wr, int wc, int fr, int fq) const {
        const int row0 = u.pm * BM + wr * 64 + fr, col0 = wc * 32 + 4 * fq;
#pragma unroll
        for (int ai = 0; ai < 2; ++ai)
#pragma unroll
            for (int m = 0; m < 4; ++m) { float* rowp = L + (size_t)(row0 + ai * HALF + m * 16) * (2 * SP) + col0;
#pragma unroll
                for (int n = 0; n < 2; ++n) *(f32x4*)(rowp + n * 16) = acc[ai][0][m][n]; }
    }
};
struct GroupOrder1 {
    int G, c, pass;
    __device__ __forceinline__ bool next(int i, Unit& u) const { const int n = pass * G + c; if (i > 0 || n >= SG * 8) return false; u.pm = n; u.pn = n >> 3; return true; }
    __device__ __forceinline__ void a_ready(const Unit&) const {}
    __device__ __forceinline__ void done(const Unit&) const {}
};
struct EpiSsmLC {
    static constexpr bool PERM = false, AFTER_DRAIN = true, MIDK = false;
    const float* AT; bf16_t* X3;
    __device__ __forceinline__ void operator()(const f32x4 (&)[2][2][4][2], const Unit&, int, int, int, int) const {}
    __device__ __forceinline__ void fused(const f32x4 (&acc)[2][2][4][2], const Unit& u, int wr, int wc, int fr, int fq, PG8_LAS unsigned char* lds, int wid, int lane) const {
        PG8_LAS float* Ls = (PG8_LAS float*)lds;
#pragma unroll
        for (int ai = 0; ai < 2; ++ai)
#pragma unroll
            for (int m = 0; m < 4; ++m)
#pragma unroll
                for (int n = 0; n < 2; ++n) { const int r = ai * HALF + wr * 64 + m * 16 + fr, q4 = 8 * wc + 4 * n + fq;
                    *(PG8_LAS f32x4*)(Ls + r * 128 + ((q4 ^ (r & 31)) << 2)) = acc[ai][0][m][n]; }
        asm volatile("s_waitcnt lgkmcnt(0)" ::: "memory"); __builtin_amdgcn_s_barrier();
        if (wid < 2) {
            const int p = lane, g = u.pm >> 3;
            const float ar = AT[(g * SP + p) * 2], ai_ = AT[(g * SP + p) * 2 + 1];
            bf16_t* xp = X3 + ((size_t)u.pm * BM + wid * 128) * X3LD + 256 + p;
            const PG8_LAS float* lw = Ls + wid * 128 * 128 + (p & 3);
            float sr = 0.f, si = 0.f;
            for (int c0 = 0; c0 < 128; c0 += 16) {
                float lr[16], li[16];
#pragma unroll
                for (int k = 0; k < 16; ++k) { const int c = c0 + k, x = c & 31; lr[k] = lw[c * 128 + (((p >> 2) ^ x) << 2)]; li[k] = lw[c * 128 + (((16 + (p >> 2)) ^ x) << 2)]; }
#pragma unroll
                for (int k = 0; k < 16; ++k) { const unsigned w = cvt_pk_bf16(sr, si);
                    xp[(size_t)(c0 + k) * X3LD] = (bf16_t)(w & 0xffffu); xp[(size_t)(c0 + k) * X3LD + SP] = (bf16_t)(w >> 16);
                    const float nr = ar * sr - ai_ * si + lr[k], ni = ar * si + ai_ * sr + li[k]; sr = nr; si = ni; }
            }
        }
        asm volatile("s_waitcnt lgkmcnt(0)" ::: "memory"); __builtin_amdgcn_s_barrier();
    }
};
__device__ __forceinline__ float gelu_tanh_e(float y) { const float z = y * (1.0f + 0.044715f * y * y) * (-2.0f * 0.7978845608028654f * LOG2E); return y * __builtin_amdgcn_rcpf(1.0f + __builtin_amdgcn_exp2f(z)); }
struct EpiSsmY {
    static constexpr bool PERM = true, AFTER_DRAIN = false, MIDK = false;
    bf16_t* ACT;
    __device__ __forceinline__ void operator()(const f32x4 (&acc)[2][2][4][2], const Unit& u, int wr, int wc, int fr, int fq) const {
        const int g = u.pn, rloc0 = (u.pm & 7) * BM + wr * 64 + fr;
        int cpart[2];
#pragma unroll
        for (int bj = 0; bj < 2; ++bj) { const int col = bj * HALF + wc * 32 + 8 * fq, i = col >> 4, cin = (g & 3) * SC + (col & 15);
            cpart[bj] = (cin >> 5) * 512 + (((i * 64 + (cin & 31) * 2) ^ (((i >> 3) & 1) << 5)) >> 1); }
#pragma unroll
        for (int ai = 0; ai < 2; ++ai)
#pragma unroll
            for (int m = 0; m < 4; ++m) { int rl = rloc0 + ai * HALF + m * 16; asm volatile("" : "+v"(rl));
                const int b = rl >> 7, c = rl & 127;
                bf16_t* base = ACT + ((size_t)(b * 8 + (c >> 4)) * (SW / BK) + (g >> 2)) * (BM * BK) + ((c >> 3) & 1) * 8192 + (c & 7) * 1024;
#pragma unroll
                for (int bj = 0; bj < 2; ++bj) {
                    f32x4 v0 = acc[ai][bj][m][0], v1 = acc[ai][bj][m][1];
#pragma unroll
                    for (int e2 = 0; e2 < 4; ++e2) { v0[e2] = gelu_tanh_e(v0[e2]); v1[e2] = gelu_tanh_e(v1[e2]); }
                    *(u32x4*)(base + cpart[bj]) = pack8(v0, v1); } }
    }
};
}
#include <hip/hip_bf16.h>
#include <cmath>
namespace attn_body {
using bf16=__hip_bfloat16;
using bf16x8=__attribute__((ext_vector_type(8)))short;
using s16x4=__attribute__((ext_vector_type(4)))short;
using f32x16=__attribute__((ext_vector_type(16)))float;
using u32x4=__attribute__((ext_vector_type(4)))unsigned;
using f32x4v=__attribute__((ext_vector_type(4)))float;
constexpr int BATCH=16,NHEAD=16,SEQ=2048,D=64,DM=NHEAD*D;
constexpr int NW=8,QBLK=32,QB=QBLK*NW,KVBLK=64,NQB=SEQ/QB;
constexpr int ATTN_PITCH=DM, ATTN_UNIT_ROWS=QB, OPITCH=2048+64;
__device__ __forceinline__ int crow(int r,int hi){return (r&3)+8*(r>>2)+4*hi;}
#define SBAR() __builtin_amdgcn_sched_barrier(0)
__device__ __forceinline__ void cmask(f32x16&p0,f32x16&p1,int jb,int qrel,int hi){
  const float NEG=-4096.0f; int kb=64*jb+4*hi;
  #pragma unroll
  for(int r=0;r<16;++r){int kv=kb+(r&3)+8*(r>>2); if(kv>qrel)p0[r]=NEG; if(kv+32>qrel)p1[r]=NEG;}
}

constexpr int NSLOT=3, SLOTB=8192;
constexpr int LDS_K=0, LDS_V=NSLOT*SLOTB, LDS_WS=2*NSLOT*SLOTB, LDS_OST=LDS_WS+NW*64*4, LDS_BYTES=LDS_OST+NW*4096;
constexpr float C2=0.125f*1.4426950408889634f;
__device__ __forceinline__ void glds16(const void*gsrc,unsigned lds_dst){unsigned keep;
  asm volatile("s_mov_b32 %0, m0\n\ts_mov_b32 m0, %2\n\ts_nop 0\n\tglobal_load_lds_dwordx4 %1, off\n\ts_mov_b32 m0, %0":"=&s"(keep):"v"(gsrc),"s"(lds_dst):"memory");}
__device__ __forceinline__ float max3f(float a,float b,float c){float r;asm("v_max3_f32 %0, %1, %2, %3":"=v"(r):"v"(a),"v"(b),"v"(c));return r;}
__device__ __forceinline__ float max2f(float a,float b){float r;asm("v_max_f32_e32 %0, %1, %2":"=v"(r):"v"(a),"v"(b));return r;}
__device__ __forceinline__ float fadd_s(float a,float b){float r;asm("v_add_f32_e32 %0, %1, %2":"=v"(r):"v"(a),"v"(b));return r;}
__device__ __forceinline__ float fsub_s(float a,float b){float r;asm("v_sub_f32_e32 %0, %1, %2":"=v"(r):"v"(a),"v"(b));return r;}
typedef float f32x2_t __attribute__((ext_vector_type(2))); typedef __bf16 bf16x2_t __attribute__((ext_vector_type(2)));
__device__ __forceinline__ unsigned cvtpk_s(float lo,float hi){f32x2_t v={lo,hi};bf16x2_t b=__builtin_convertvector(v,bf16x2_t);return __builtin_bit_cast(unsigned,b);}
#define WAIT_BAR(N) asm volatile("s_waitcnt vmcnt(" #N ") lgkmcnt(0)\n\ts_barrier":::"memory")

__device__ __forceinline__ void qkt(f32x16&p0,f32x16&p1,const char*Kslot,const bf16x8*qr,int r32,int hi){
  const char*kb=Kslot+hi*1024+r32*16;
  #pragma unroll
  for(int d0=0;d0<4;++d0){
    const bf16x8 b0=*reinterpret_cast<const bf16x8*>(kb+d0*2048);
    const bf16x8 b1=*reinterpret_cast<const bf16x8*>(kb+d0*2048+512);
    p0=__builtin_amdgcn_mfma_f32_32x32x16_bf16(b0,qr[d0],p0,0,0,0);p1=__builtin_amdgcn_mfma_f32_32x32x16_bf16(b1,qr[d0],p1,0,0,0);}
}
typedef __attribute__((address_space(3))) const char* lds_cptr;
typedef short v4i16_t __attribute__((ext_vector_type(4)));
__device__ __forceinline__ void kload8(bf16x8*kf,lds_cptr kp){
  kf[0]=*(const __attribute__((address_space(3))) bf16x8*)(kp);      kf[1]=*(const __attribute__((address_space(3))) bf16x8*)(kp+512);
  kf[2]=*(const __attribute__((address_space(3))) bf16x8*)(kp+2048); kf[3]=*(const __attribute__((address_space(3))) bf16x8*)(kp+2560);
  kf[4]=*(const __attribute__((address_space(3))) bf16x8*)(kp+4096); kf[5]=*(const __attribute__((address_space(3))) bf16x8*)(kp+4608);
  kf[6]=*(const __attribute__((address_space(3))) bf16x8*)(kp+6144); kf[7]=*(const __attribute__((address_space(3))) bf16x8*)(kp+6656);
}
__device__ __forceinline__ void kload2(bf16x8*kf,lds_cptr kp,int j){ kf[2*j]=*(const __attribute__((address_space(3))) bf16x8*)(kp+j*2048); kf[2*j+1]=*(const __attribute__((address_space(3))) bf16x8*)(kp+j*2048+512); }
__device__ __forceinline__ s16x4 vtr(lds_cptr p){ return __builtin_bit_cast(s16x4,__builtin_amdgcn_ds_read_tr16_b64_v4i16((__attribute__((address_space(3))) v4i16_t*)p)); }
__device__ __forceinline__ float rowmax(const f32x16&p0,const f32x16&p1){
  float a=max3f(p0[0],p0[1],p1[0]),b=max3f(p0[2],p0[3],p1[1]);a=max3f(a,p1[2],p1[3]);
  #pragma unroll
  for(int r=4;r<16;r+=4){a=max3f(a,p0[r],p0[r+1]);b=max3f(b,p0[r+2],p0[r+3]);a=max3f(a,p1[r],p1[r+1]);b=max3f(b,p1[r+2],p1[r+3]);}
  const float m=max2f(a,b);
  auto rr=__builtin_amdgcn_permlane32_swap(__float_as_uint(m),__float_as_uint(m),false,false);
  return max2f(__uint_as_float(rr[0]),__uint_as_float(rr[1]));
}
__device__ __forceinline__ void pv(f32x16*o,int vb,bf16x8 pa0,bf16x8 pa1,bf16x8 pa2,bf16x8 pa3){
  #pragma unroll
  for(int d0=0;d0<2;++d0){s16x4 lo[4],hi[4];
    #pragma unroll
    for(int ks=0;ks<4;++ks){
      asm volatile("ds_read_b64_tr_b16 %0,%1 offset:%c2":"=&v"(lo[ks]):"v"(vb),"i"(d0*4096+ks*1024):"memory");
      asm volatile("ds_read_b64_tr_b16 %0,%1 offset:%c2":"=&v"(hi[ks]):"v"(vb),"i"(d0*4096+ks*1024+512):"memory");}
    asm volatile("s_waitcnt lgkmcnt(0)":::"memory");SBAR();
    #define PK(k) (bf16x8){lo[k][0],lo[k][1],lo[k][2],lo[k][3],hi[k][0],hi[k][1],hi[k][2],hi[k][3]}
    o[d0]=__builtin_amdgcn_mfma_f32_32x32x16_bf16(pa0,PK(0),o[d0],0,0,0);
    o[d0]=__builtin_amdgcn_mfma_f32_32x32x16_bf16(pa1,PK(1),o[d0],0,0,0);
    o[d0]=__builtin_amdgcn_mfma_f32_32x32x16_bf16(pa2,PK(2),o[d0],0,0,0);
    o[d0]=__builtin_amdgcn_mfma_f32_32x32x16_bf16(pa3,PK(3),o[d0],0,0,0);
    #undef PK
  }
}

#ifndef ATTN_STORE16
#define ATTN_STORE16(p,v) (*(u32x4*)(p)=(v))
#endif
template<int THRL> __device__ __forceinline__ void attn_unit(int b,int h,int qb,const bf16*Q,const bf16*__restrict__ K,const bf16*__restrict__ V,bf16*O,const float*kmean,float*rowsq,char*shm,bool pref,bool hn,int nb,int nh,int nqb,bf16x8(&qn)[4]){
  int tid_=threadIdx.x; asm volatile("":"+v"(tid_)); const int tid=tid_,lane=tid&63,r32=lane&31,hi=lane>>5; const int wid=__builtin_amdgcn_readfirstlane(tid>>6);
  const long rowbase=(long)b*SEQ; const int q0=qb*QB;
  const bf16*Qw=Q+(rowbase+q0+wid*QBLK)*DM+h*D;
  const bf16*Kh=K+(long)(b*NHEAD+h)*(SEQ*D),*Vh=V+(long)(b*NHEAD+h)*(SEQ*D);
  const unsigned lds0=(unsigned)(uintptr_t)shm;
  float*wsf=(float*)(shm+LDS_WS)+wid*64;
  const bf16*ksrc=Kh+wid*512+lane*8;
  const bf16*vsrc=Vh+wid*512+lane*8;
  const unsigned kdst=lds0+LDS_K+wid*1024, vdst=lds0+LDS_V+wid*1024;
  #define DMA_K(t,slot) glds16(ksrc+(long)(NTF-1-(t))*(KVBLK*D),(unsigned)__builtin_amdgcn_readfirstlane(kdst+(slot)))
  #define DMA_V(t,slot) glds16(vsrc+(long)(NTF-1-(t))*(KVBLK*D),(unsigned)__builtin_amdgcn_readfirstlane(vdst+(slot)))
  const int vb0=(int)(lds0+LDS_V)+((lane>>4)&1)*32+(lane&3)*8+(4*hi+((lane&15)>>2))*64;
  const char*Kbase=shm+LDS_K; bf16x8 kf[8];
  const lds_cptr shm3=(lds_cptr)shm; const lds_cptr kp0=shm3+LDS_K+hi*1024+r32*16; const lds_cptr vp0=shm3+LDS_V+((lane>>4)&1)*32+(lane&3)*8+(4*hi+((lane&15)>>2))*64;
  const float sl2=__builtin_amdgcn_exp2f(-0.5f*(float)(h+1))*1.4426950408889634f;
  const int NTF=(q0+QB)/KVBLK;
  int npt_=(int)((182.0f/sl2+63.0f)*(1.0f/64.0f)); npt_+=npt_&1; npt_=__builtin_amdgcn_readfirstlane(npt_);
  const int NT=(4+npt_<NTF)?4+npt_:NTF;
  if(!pref){DMA_K(0,0);DMA_V(0,0);DMA_K(1,SLOTB);}
  bf16x8 qr[4];
  #pragma unroll
  for(int d0=0;d0<4;++d0)qr[d0]=pref?qn[d0]:*reinterpret_cast<const bf16x8*>(&Qw[(long)r32*DM+d0*16+hi*8]);
  float mhat=0.f,l_reg=0.f;f32x16 o[2];o[0]=f32x16{};o[1]=f32x16{};
  unsigned selm=0u;
  if(qb>0){ float gate[7];
    #pragma unroll
    for(int j=0;j<7;++j){ float sg=0.f;
      if(j<qb){ const float*km=kmean+((long)(b*NHEAD+h)*8+j)*D+hi*8;
        #pragma unroll
        for(int d0=0;d0<4;++d0){ const f32x4v ka=*reinterpret_cast<const f32x4v*>(km+d0*16),kb2=*reinterpret_cast<const f32x4v*>(km+d0*16+4); const bf16x8 qv=qr[d0];
          #define QF(i) __builtin_bit_cast(float,((unsigned)(unsigned short)qv[i])<<16)
          sg+=(QF(0)*ka[0]+QF(1)*ka[1])+(QF(2)*ka[2]+QF(3)*ka[3])+(QF(4)*kb2[0]+QF(5)*kb2[1])+(QF(6)*kb2[2]+QF(7)*kb2[3]);
          #undef QF
        }
        sg=xsum32(sg); }
      gate[j]=sg; }
    #pragma unroll
    for(int j=0;j<7;++j) if(j<qb){ int cnt=0;
      #pragma unroll
      for(int i=0;i<7;++i) if(i!=j&&i<qb) cnt+=(gate[i]>gate[j]||(gate[i]==gate[j]&&i<j))?1:0;
      if(cnt<3) selm|=1u<<j; } }
  const float hib=sl2*(float)(4*hi);
  #define CINIT(C0,C1,t) do{ const int t_=(t); const bool on_=(t_<4)||(((selm>>((NTF-1-t_)>>2))&1u)!=0u); \
    const float bs_=on_?(sl2*(float)(64*(3-t_))+hib-mhat):-4096.0f; \
    const f32x2_t sv_={sl2,sl2},bv_={bs_,bs_},dv_={32.0f*sl2,32.0f*sl2}; \
    _Pragma("unroll") for(int r=0;r<16;r+=2){ const float kc_=(float)((r&3)+8*(r>>2)); const f32x2_t kk_={kc_,kc_+1.0f}; const f32x2_t r0_=sv_*kk_+bv_, r1_=r0_+dv_; \
      C0[r]=r0_.x; C0[r+1]=r0_.y; C1[r]=r1_.x; C1[r+1]=r1_.y; } }while(0)
  const int qrel=wid*QBLK+r32;
  #define CMASK(P0,P1,t) do{int jb_=3-(t); if(jb_>=0)cmask(P0,P1,jb_,qrel,hi);}while(0)
  bool resc=false;
  #define START(P0,P1) do{ const float rm=rowmax(P0,P1); resc=false; \
    { const float dl=rm; mhat=fadd_s(mhat,dl); \
      _Pragma("unroll") for(int r=0;r<16;++r){P0[r]=fsub_s(P0[r],dl);P1[r]=fsub_s(P1[r],dl);} \
      } \
    _Pragma("unroll") for(int r=0;r<16;++r)P0[r]=__builtin_amdgcn_exp2f(P0[r]); }while(0)
  #define RESC() do{ if(resc){ asm volatile("s_waitcnt lgkmcnt(0)":::"memory"); \
      _Pragma("unroll") for(int d_=0;d_<2;++d_) _Pragma("unroll") for(int r=0;r<16;++r)o[d_][r]*=wsf[crow(r,hi)]; } }while(0)
  f32x16 pA0,pA1,pB0,pB1;
  int sl_prev=0,sl_cur=0,sl_next=SLOTB;
  #define ROT() do{sl_prev=sl_cur;sl_cur=sl_next;sl_next=(sl_next==(NSLOT-1)*SLOTB)?0:sl_next+SLOTB;}while(0)
  DMA_K(2,2*SLOTB);
  WAIT_BAR(3);
  CINIT(pA0,pA1,0);qkt(pA0,pA1,Kbase,qr,r32,hi);asm volatile("s_nop 15\n\ts_nop 7":"+v"(pA0),"+v"(pA1));CMASK(pA0,pA1,0);
  START(pA0,pA1);
  _Pragma("unroll") for(int r=0;r<16;++r)pA1[r]=__builtin_amdgcn_exp2f(pA1[r]);
  WAIT_BAR(0);
  DMA_K(3,0);DMA_V(1,SLOTB);
  ROT();
  kload8(kf,kp0+sl_cur);
  WAIT_BAR(2);
  s16x4 vlo[8],vhi[8]; u32x4 pw0,pw1,pw2,pw3;
  #define PKW(P,B) cvtpk_s(P[B],P[B+1])
  #define PAF(k) __builtin_bit_cast(bf16x8,pw##k)
  #define VFR(i) (bf16x8){vlo[i][0],vlo[i][1],vlo[i][2],vlo[i][3],vhi[i][0],vhi[i][1],vhi[i][2],vhi[i][3]}
  #define PIN(x) asm volatile("":"+v"(x))
  #define MX3(a,b,c) __builtin_fmaxf(__builtin_fmaxf((a),(b)),(c))
  #define GAPA(MF,A0,A1,A2,A3,W0,W1,PW) do{ MF; sacc+=A0; sacc+=A1; sacc+=A2; sacc+=A3; PIN(sacc); W0; W1; PIN(PW); SBAR(); }while(0)
  #define EX(v) __builtin_amdgcn_exp2f(v)
  #define GAPB(MF,X,B) do{ MF; X[B]=EX(X[B]); X[B+1]=EX(X[B+1]); X[B+2]=EX(X[B+2]); X[B+3]=EX(X[B+3]); PIN(X); SBAR(); }while(0)
  #define VRD(i) do{ vlo[i]=vtr(vp_+(((i)>>2)*4096+((i)&3)*1024)); vhi[i]=vtr(vp_+(((i)>>2)*4096+((i)&3)*1024+512)); }while(0)
  #define KRD(G,j) do{ if(G){ kload2(kf,kp0+sl_next,j); SBAR(); } }while(0)
  #define STEP(C0,C1,P0,P1,t,GK,GV,GL) do{ SBAR(); CINIT(C0,C1,t); SBAR(); \
    const lds_cptr vp_=vp0+sl_prev; \
    VRD(0); SBAR(); float sacc=(P0[0]+P0[1]); \
    GAPA(C0=__builtin_amdgcn_mfma_f32_32x32x16_bf16(kf[0],qr[0],C0,0,0,0), P0[2],P0[3],P0[4],P0[5],     pw0[0]=PKW(P0,0), pw0[1]=PKW(P0,2), pw0); \
    VRD(4); SBAR(); GAPA(C1=__builtin_amdgcn_mfma_f32_32x32x16_bf16(kf[1],qr[0],C1,0,0,0), P0[6],P0[7],P0[8],P0[9],     pw0[2]=PKW(P0,4), pw0[3]=PKW(P0,6), pw0); \
    VRD(1); SBAR(); GAPA(C0=__builtin_amdgcn_mfma_f32_32x32x16_bf16(kf[2],qr[1],C0,0,0,0),   P0[10],P0[11],P0[12],P0[13], pw1[0]=PKW(P0,8), pw1[1]=PKW(P0,10), pw1); \
    VRD(5); SBAR(); GAPA(C1=__builtin_amdgcn_mfma_f32_32x32x16_bf16(kf[3],qr[1],C1,0,0,0),   P0[14],P0[15],P1[0],P1[1],   pw1[2]=PKW(P0,12),pw1[3]=PKW(P0,14), pw1); \
    VRD(2); SBAR(); GAPA(C0=__builtin_amdgcn_mfma_f32_32x32x16_bf16(kf[4],qr[2],C0,0,0,0),   P1[2],P1[3],P1[4],P1[5],     pw2[0]=PKW(P1,0), pw2[1]=PKW(P1,2), pw2); \
    VRD(6); SBAR(); GAPA(C1=__builtin_amdgcn_mfma_f32_32x32x16_bf16(kf[5],qr[2],C1,0,0,0),   P1[6],P1[7],P1[8],P1[9],     pw2[2]=PKW(P1,4), pw2[3]=PKW(P1,6), pw2); \
    VRD(3); SBAR(); GAPA(C0=__builtin_amdgcn_mfma_f32_32x32x16_bf16(kf[6],qr[3],C0,0,0,0),   P1[10],P1[11],P1[12],P1[13], pw3[0]=PKW(P1,8), pw3[1]=PKW(P1,10), pw3); \
    VRD(7); SBAR(); GAPA(C1=__builtin_amdgcn_mfma_f32_32x32x16_bf16(kf[7],qr[3],C1,0,0,0),   P1[14],P1[15],0.f,0.f,       pw3[2]=PKW(P1,12),pw3[3]=PKW(P1,14), pw3); \
    l_reg+=sacc; \
    if(GK){DMA_K((t)+3,sl_cur);} if(GV){DMA_V((t)+1,sl_next);} \
    CMASK(C0,C1,t); \
    { float a=MX3(C0[0],C0[1],C1[0]),b=MX3(C0[2],C0[3],C1[1]); a=MX3(a,C1[2],C1[3]); \
      _Pragma("unroll") for(int r=4;r<16;r+=4){a=MX3(a,C0[r],C0[r+1]);b=MX3(b,C0[r+2],C0[r+3]);a=MX3(a,C1[r],C1[r+1]);b=MX3(b,C1[r+2],C1[r+3]);} \
      float rm=__builtin_fmaxf(a,b); { auto rr=__builtin_amdgcn_permlane32_swap(__float_as_uint(rm),__float_as_uint(rm),false,false); rm=__builtin_fmaxf(__uint_as_float(rr[0]),__uint_as_float(rr[1])); } \
      resc=false; \
      if(__builtin_expect(__any(rm>(float)THRL),0)){ const float dl=__builtin_fmaxf(rm,0.f); mhat+=dl; \
        _Pragma("unroll") for(int r=0;r<16;++r){C0[r]-=dl;C1[r]-=dl;} \
        const float f=__builtin_amdgcn_exp2f(-dl); l_reg*=f; if(hi==0)wsf[r32]=f; resc=true; } } \
    SBAR(); \
    GAPB(o[0]=__builtin_amdgcn_mfma_f32_32x32x16_bf16(PAF(0),VFR(0),o[0],0,0,0), C0,0); \
    GAPB(o[1]=__builtin_amdgcn_mfma_f32_32x32x16_bf16(PAF(0),VFR(4),o[1],0,0,0), C0,4); \
    KRD(GL,0); GAPB(o[0]=__builtin_amdgcn_mfma_f32_32x32x16_bf16(PAF(1),VFR(1),o[0],0,0,0), C0,8); \
    KRD(GL,1); GAPB(o[1]=__builtin_amdgcn_mfma_f32_32x32x16_bf16(PAF(1),VFR(5),o[1],0,0,0), C0,12); \
    KRD(GL,2); GAPB(o[0]=__builtin_amdgcn_mfma_f32_32x32x16_bf16(PAF(2),VFR(2),o[0],0,0,0), C1,0); \
    KRD(GL,3); GAPB(o[1]=__builtin_amdgcn_mfma_f32_32x32x16_bf16(PAF(2),VFR(6),o[1],0,0,0), C1,4); \
    GAPB(o[0]=__builtin_amdgcn_mfma_f32_32x32x16_bf16(PAF(3),VFR(3),o[0],0,0,0), C1,8); \
    GAPB(o[1]=__builtin_amdgcn_mfma_f32_32x32x16_bf16(PAF(3),VFR(7),o[1],0,0,0), C1,12); \
    }while(0)
  int t=1;
  for(;t+5<NT;t+=2){
    STEP(pB0,pB1,pA0,pA1,t,true,true,true);     WAIT_BAR(2); RESC(); ROT();
    STEP(pA0,pA1,pB0,pB1,t+1,true,true,true);   WAIT_BAR(2); RESC(); ROT();
  }
  #define ENDW(tt) do{ if((tt)+3<NT){WAIT_BAR(2);} else if((tt)+2<NT){WAIT_BAR(1);} else {WAIT_BAR(0);} }while(0)
  for(;t+1<NT;t+=2){
    STEP(pB0,pB1,pA0,pA1,t,(t+3<NT),(t+1<NT),(t+1<NT));       ENDW(t);   RESC(); ROT();
    STEP(pA0,pA1,pB0,pB1,t+1,(t+4<NT),(t+2<NT),(t+2<NT));     ENDW(t+1); RESC(); ROT();
  }
  STEP(pB0,pB1,pA0,pA1,NT-1,false,false,false); RESC();
  { float sacc=pB0[0]+pB0[1]; _Pragma("unroll") for(int r=2;r<16;++r)sacc+=pB0[r]; _Pragma("unroll") for(int r=0;r<16;++r)sacc+=pB1[r]; l_reg+=sacc;
    pw0=(u32x4){PKW(pB0,0),PKW(pB0,2),PKW(pB0,4),PKW(pB0,6)};pw1=(u32x4){PKW(pB0,8),PKW(pB0,10),PKW(pB0,12),PKW(pB0,14)};pw2=(u32x4){PKW(pB1,0),PKW(pB1,2),PKW(pB1,4),PKW(pB1,6)};pw3=(u32x4){PKW(pB1,8),PKW(pB1,10),PKW(pB1,12),PKW(pB1,14)};
    SBAR(); pv(o,vb0+sl_cur,PAF(0),PAF(1),PAF(2),PAF(3)); }
  if(hn){ asm volatile("s_waitcnt lgkmcnt(0)\n\ts_barrier":::"memory");
    const bf16*nK=K+(long)(nb*NHEAD+nh)*(SEQ*D)+wid*512+lane*8,*nV=V+(long)(nb*NHEAD+nh)*(SEQ*D)+wid*512+lane*8; const int nNTF=(nqb*QB+QB)/KVBLK;
    glds16(nK+(long)(nNTF-1)*(KVBLK*D),(unsigned)__builtin_amdgcn_readfirstlane(kdst)); glds16(nV+(long)(nNTF-1)*(KVBLK*D),(unsigned)__builtin_amdgcn_readfirstlane(vdst)); glds16(nK+(long)(nNTF-2)*(KVBLK*D),(unsigned)__builtin_amdgcn_readfirstlane(kdst+SLOTB));
    const bf16*nQ=Q+((long)nb*SEQ+nqb*QB+wid*QBLK)*DM+nh*D;
    #pragma unroll
    for(int d0=0;d0<4;++d0)qn[d0]=*reinterpret_cast<const bf16x8*>(&nQ[(long)r32*DM+d0*16+hi*8]); }
  #undef PKW
  #undef PAF
  #undef VFR
  #undef PIN
  #undef MX3
  #undef GAPA
  #undef GAPB
  #undef EX
  #undef VRD
  #undef KRD
  #undef STEP
  #undef ENDW
  {auto rr=__builtin_amdgcn_permlane32_swap(__float_as_uint(l_reg),__float_as_uint(l_reg),false,false);l_reg=__uint_as_float(rr[0])+__uint_as_float(rr[1]);}
  if(hi==0)wsf[32+r32]=l_reg;asm volatile("s_waitcnt lgkmcnt(0)":::"memory");
  float rli[16];
  #pragma unroll
  for(int r=0;r<16;++r)rli[r]=__builtin_amdgcn_rcpf(wsf[32+crow(r,hi)]);
  bf16*Ow=O+(((rowbase+q0)>>8)*32+h)*16384L; float*sqw=rowsq+(rowbase+q0+wid*QBLK);
  { bf16*stg=(bf16*)(shm+LDS_OST)+wid*2048;
    #pragma unroll
    for(int r=0;r<16;++r){const int orow=crow(r,hi);
      #pragma unroll
      for(int d0=0;d0<2;++d0)stg[orow*64+d0*32+r32]=__float2bfloat16(o[d0][r]*rli[r]);}
    asm volatile("s_waitcnt lgkmcnt(0)":::"memory");
    #pragma unroll
    for(int i=0;i<4;++i){const int row=i*8+(lane>>3),ch=lane&7; const u32x4 v=*(const u32x4*)(stg+row*64+ch*8); ATTN_STORE16(Ow+pg8::img_in(wid*QBLK+row,ch*8),v);
      #define BL(w) __builtin_bit_cast(float,(w)<<16)
      #define BH(w) __builtin_bit_cast(float,(w)&0xffff0000u)
      float ss=(BL(v.x)*BL(v.x)+BH(v.x)*BH(v.x))+(BL(v.y)*BL(v.y)+BH(v.y)*BH(v.y))+(BL(v.z)*BL(v.z)+BH(v.z)*BH(v.z))+(BL(v.w)*BL(v.w)+BH(v.w)*BH(v.w));
      #undef BL
      #undef BH
      ss+=shx<1>(ss); ss+=shx<2>(ss); ss+=shx<4>(ss);
      if(ch==0)__hip_atomic_fetch_add(sqw+row,ss,__ATOMIC_RELAXED,__HIP_MEMORY_SCOPE_AGENT); } }
  asm volatile("s_waitcnt lgkmcnt(0)\n\ts_barrier":::"memory");
  #undef DMA_K
  #undef DMA_V
  #undef CMASK
  #undef CINIT
  #undef START
  #undef RESC
  #undef ROT
}
constexpr int ATTN_LDS_BYTES=LDS_BYTES;
struct AttnTensors { const bf16* Q; const bf16* K; const bf16* V; bf16* O; const float* kmean; float* rowsq; };
struct AttnUnit { int bh; int qb; };
__device__ constexpr unsigned char ATT_TAB[16][8]={{127,101,68,37,26,33,1,0},{119,93,60,36,23,49,7,48},{111,85,52,35,22,41,6,40},{103,77,47,122,90,21,5,32},{95,69,46,114,82,20,4,24},{87,61,45,106,74,19,3,16},{79,53,44,98,66,18,2,8},{71,124,108,91,58,121,25,120},
  {63,116,100,83,50,113,17,112},{126,70,123,75,42,105,15,104},{118,62,115,67,34,97,14,96},{110,55,107,59,31,89,13,88},{102,54,99,51,30,81,12,80},{94,125,92,43,29,73,11,72},{86,117,84,39,28,65,10,64},{78,109,76,38,27,57,9,56}};
struct StaticOrder {
  int vcu,grid;
  __device__ __forceinline__ explicit StaticOrder(int grid_,int vcu_):vcu(vcu_),grid(grid_){}
  __device__ __forceinline__ bool next(int i,AttnUnit&u)const{ const int n=i*grid+vcu; if(n>=BATCH*NHEAD*NQB)return false; const int sid=n%(BATCH*NHEAD),code=ATT_TAB[sid&15][n/(BATCH*NHEAD)]; u.bh=(sid>>4)*NHEAD+(code>>3); u.qb=code&7; return true; }
  __device__ __forceinline__ void a_ready(const AttnUnit&)const{}
  __device__ __forceinline__ void done(const AttnUnit&)const{}
};
template<class Sched,int THRL=8> __device__ __forceinline__ void attn_phase(char*lds,const AttnTensors&T,const Sched&S){
  AttnUnit u,un; bf16x8 qn[4]; qn[0]=qn[1]=qn[2]=qn[3]=bf16x8{}; bool pref=false; bool has=S.next(0,u);
  for(int i=0;has;++i){ const bool hn=S.next(i+1,un); S.a_ready(u);
    attn_unit<THRL>(u.bh/NHEAD,u.bh%NHEAD,u.qb,T.Q,T.K,T.V,T.O,T.kmean,T.rowsq,lds,pref,hn,un.bh/NHEAD,un.bh%NHEAD,un.qb,qn); S.done(u); u=un; has=hn; pref=hn; }
}
#undef SBAR
#undef WAIT_BAR
}
#define GAS __attribute__((address_space(1)))
#define LAS __attribute__((address_space(3)))
typedef unsigned short bf16;
typedef unsigned v4u __attribute__((ext_vector_type(4)));
typedef float f32x4 __attribute__((ext_vector_type(4)));
typedef short bf16x8 __attribute__((ext_vector_type(8)));
typedef GAS unsigned gu32;
typedef GAS unsigned long long gu64;
#define RLX_AGENT __ATOMIC_RELAXED, __HIP_MEMORY_SCOPE_AGENT
#define LDS_WAIT() asm volatile("s_waitcnt lgkmcnt(0)" ::: "memory")
#define VM_WAIT() asm volatile("s_waitcnt vmcnt(0)" ::: "memory")
__device__ __forceinline__ unsigned long long rt() { return __builtin_amdgcn_s_memrealtime(); }
__device__ __forceinline__ unsigned f2bf(float f) { unsigned u = __builtin_bit_cast(unsigned, f); return (u + 0x7fffu + ((u >> 16) & 1u)) >> 16; }
__device__ __forceinline__ unsigned pk2(float lo, float hi) { return f2bf(lo) | (f2bf(hi) << 16); }

#define XB_TMO      128
#define XB_XCNT(j)  (256  + 64 * (j))
#define XB_XSUB(j)  (1280 + 64 * (j))
#define XB_XGEN(j)  (2304 + 64 * (j))
#define XB_TOP      3328
#define XB_TOPGEN   3392
#define XCD_BAR_WORDS 3456
#define XB_SPIN_CAP (1u << 18)

__device__ __forceinline__ unsigned xb_ld(unsigned* p)              { return __hip_atomic_load(p, __ATOMIC_RELAXED, __HIP_MEMORY_SCOPE_AGENT); }
__device__ __forceinline__ unsigned xb_add(unsigned* p, unsigned v) { return __hip_atomic_fetch_add(p, v, __ATOMIC_RELAXED, __HIP_MEMORY_SCOPE_AGENT); }
__device__ __forceinline__ unsigned xb_xcc_id() { return (unsigned)__builtin_amdgcn_s_getreg((3 << 11) | 20) & 0xFu; }
#define XB_SPIN(cond, bar) do { unsigned _sp = 0; while (cond) { __builtin_amdgcn_s_sleep(1); \
    if ((++_sp & 255u) == 0u) { if (xb_ld(&(bar)[XB_TMO])) break; if (_sp > XB_SPIN_CAP) { atomicAdd(&(bar)[XB_TMO], 1u); break; } } } } while (0)

struct XcdBarrier {
    unsigned* bar; unsigned x;
    volatile LAS unsigned* st;
};

__device__ __forceinline__ XcdBarrier xcd_barrier_post(unsigned* bar, volatile LAS unsigned* st) {
    XcdBarrier b; b.bar = bar; b.x = xb_xcc_id(); b.st = st;
    if (threadIdx.x == 0) (void)xb_add(&bar[XB_XCNT(b.x)], 1u);
    return b;
}
__device__ __forceinline__ void xcd_barrier_complete(unsigned* bar, unsigned x, unsigned& nloc, unsigned& nx) {
    const unsigned G = gridDim.x * gridDim.y * gridDim.z;
    unsigned sum, cnt, mine, sp = 0u;
    for (;;) {
        sum = 0u; cnt = 0u; mine = 0u;
#pragma unroll
        for (unsigned j = 0; j < 16; ++j) { const unsigned c = xb_ld(&bar[XB_XCNT(j)]); sum += c; cnt += (c > 0u) ? 1u : 0u; mine = (j == x) ? c : mine; }
        if (sum == G) break;
        __builtin_amdgcn_s_sleep(1);
        if ((++sp & 255u) == 0u) { if (xb_ld(&bar[XB_TMO])) break; if (sp > XB_SPIN_CAP) { atomicAdd(&bar[XB_TMO], 1u); break; } }
    }
    nloc = mine > 0u ? mine : 1u; nx = cnt > 0u ? cnt : 1u;
}

__device__ __forceinline__ void xcd_barrier(const XcdBarrier& b) {
    asm volatile("s_waitcnt vmcnt(0)" ::: "memory");
    __syncthreads();
    if (threadIdx.x == 0) {
        unsigned* bar = b.bar;
        __builtin_amdgcn_s_waitcnt(0);
        unsigned nloc = b.st[0], nx = b.st[1];
        if (nloc == 0u) { xcd_barrier_complete(bar, b.x, nloc, nx); b.st[0] = nloc; b.st[1] = nx; }
        const unsigned old = xb_add(&bar[XB_XSUB(b.x)], 1u);
        const unsigned gen = old / nloc;
        if (old + 1u == (gen + 1u) * nloc) {
            __builtin_amdgcn_fence(__ATOMIC_RELEASE, "agent");
            asm volatile("s_waitcnt vmcnt(0)" ::: "memory");
            const unsigned og = xb_add(&bar[XB_TOP], 1u);
            const unsigned tg = og / nx;
            if (og + 1u == (tg + 1u) * nx) xb_add(&bar[XB_TOPGEN], 1u);
            else XB_SPIN(xb_ld(&bar[XB_TOPGEN]) == tg, bar);
            __builtin_amdgcn_fence(__ATOMIC_ACQUIRE, "agent");
            xb_add(&bar[XB_XGEN(b.x)], 1u);
            asm volatile("s_waitcnt vmcnt(0)" ::: "memory");
        } else {
            XB_SPIN(xb_ld(&bar[XB_XGEN(b.x)]) == gen, bar);
            __builtin_amdgcn_fence(__ATOMIC_ACQUIRE, "agent");
            asm volatile("s_waitcnt vmcnt(0)" ::: "memory");
        }
    }
    __syncthreads();
}

__device__ __forceinline__ void group_barrier(unsigned* ctr, unsigned target, unsigned* bar) {
    asm volatile("s_waitcnt vmcnt(0)" ::: "memory");
    __syncthreads();
    if (threadIdx.x == 0) {
        __builtin_amdgcn_s_waitcnt(0);
        __builtin_amdgcn_fence(__ATOMIC_RELEASE, "agent");
        asm volatile("s_waitcnt vmcnt(0)" ::: "memory");
        (void)xb_add(ctr, 1u);
        XB_SPIN(xb_ld(ctr) < target, bar);
        __builtin_amdgcn_fence(__ATOMIC_ACQUIRE, "agent");
        asm volatile("s_waitcnt vmcnt(0)" ::: "memory");
    }
    __syncthreads();
}

constexpr int NWAVES = 8;
constexpr size_t MiB = 1u << 20;
constexpr size_t WS_CTL = 0, CTL_ZERO_BYTES = 2 * MiB;
constexpr size_t WS_KMEAN = 1 * MiB;
constexpr size_t WS_ROWSQ = 1 * MiB + 512 * 1024;
constexpr size_t WS_WIN = 2 * MiB, WS_WGLU = 19 * MiB, WS_WOUT = 22 * MiB, WS_W1 = 31 * MiB, WS_W2 = 65 * MiB;
constexpr size_t WS_W3 = 98 * MiB, WS_F = 110 * MiB, WS_AT = 118 * MiB;
constexpr size_t WS_X1B = 120 * MiB;
constexpr size_t WS_HID = 256 * MiB;
constexpr size_t WS_XB = 772 * MiB;
constexpr size_t WS_Q = 388 * MiB, WS_K = 452 * MiB, WS_V = 516 * MiB;
constexpr size_t WS_X3 = 580 * MiB;
constexpr size_t WS_L = 676 * MiB;
constexpr size_t WS_ACT = 900 * MiB, WS_END = 964 * MiB;
static_assert(WS_WIN + (size_t)NPROJ * LDM * 2 <= WS_WGLU && WS_WGLU + (size_t)SW * LDS1 * 2 <= WS_WOUT && WS_WOUT + (size_t)DM * LDM * 2 <= WS_W1 && WS_W1 + (size_t)DFF * LDM * 2 <= WS_W2 && WS_W2 + (size_t)DM * LDF * 2 <= WS_W3, "weight map");
static_assert(WS_X1B + (size_t)MTOK * LDM * 2 <= WS_HID && WS_HID + (size_t)MTOK * DM * 2 <= WS_Q && WS_L + (size_t)SG * BATCH * NCH * 128 * 4 <= WS_XB && WS_HID + (size_t)MTOK * LDF * 2 <= WS_XB && WS_XB + (size_t)MTOK * DM * 2 <= WS_ACT && WS_ACT + (size_t)MTOK * SW * 2 <= WS_END, "activation map");
constexpr int CW_TMO = 0, CW_CODE = 1, CW_BAR = 4096, CW_TS = 16384, CW_XQ = 8192, CW_GB = 12288;

constexpr int RING_OFF = 0, RING_BYTES = 131072;
constexpr int LDSCTL_OFF = RING_BYTES, MISC_OFF = LDSCTL_OFF + 320;
constexpr int LDS_BYTES = 147456;

struct Args { const float* in[21]; float* out; unsigned char* ws; };
struct Frame {
    LAS unsigned char* lds;
    volatile LAS unsigned* MISC;
    gu32* ctl;
    int tid, lane, wave, vcu, G;
};
__device__ __forceinline__ float wave_sum(float v) {
    v += shx<1>(v); v += shx<2>(v); v += shx<4>(v); v += shx<8>(v); v += shx<16>(v);
    return xsum32(v);
}
__device__ __forceinline__ float bflo(unsigned w) { return __builtin_bit_cast(float, w << 16); }
__device__ __forceinline__ float bfhi(unsigned w) { return __builtin_bit_cast(float, w & 0xffff0000u); }
__device__ __forceinline__ float gelu_tanh(float y) {
    const float z = y * (1.0f + 0.044715f * y * y) * (-2.0f * 0.7978845608028654f * LOG2E);
    return y * __builtin_amdgcn_rcpf(1.0f + __builtin_amdgcn_exp2f(z));
}

__device__ __forceinline__ void ssm_precompute(Frame& F, const Args& A, int g, bf16* W3, bf16* FM, float* AT) {
    LAS float* pwr = (LAS float*)(F.lds + RING_OFF);
    LAS float* pwi = pwr + 17 * 64;
    LAS float* bbr = pwi + 17 * 64;
    LAS float* bbi = bbr + 64 * 16;
    LAS float* ccr = bbi + 64 * 16;
    LAS float* cci = ccr + 16 * 64;
    LAS float* ktab = cci + 16 * 64;
    const int tid = F.tid;
    if (tid < 64) {
        const int p = tid;
        const float dt = expf(A.in[8][g]);
        const float lr = A.in[6][g * SP + p], li = A.in[7][g * SP + p];
        const float mag = expf(lr * dt), a_re = mag * cosf(li * dt), a_im = mag * sinf(li * dt);
        const float den = lr * lr + li * li, nr = a_re - 1.0f;
        const float f_re = (nr * lr + a_im * li) / den, f_im = (a_im * lr - nr * li) / den;
        float pr = 1.0f, pi = 0.0f;
        for (int t = 0; t <= 16; ++t) { pwr[t * 64 + p] = pr; pwi[t * 64 + p] = pi; const float nr2 = pr * a_re - pi * a_im, ni2 = pr * a_im + pi * a_re; pr = nr2; pi = ni2; }
        AT[(g * SP + p) * 2] = pwr[16 * 64 + p]; AT[(g * SP + p) * 2 + 1] = pwi[16 * 64 + p];
        for (int h = 0; h < 16; ++h) { const float br = A.in[9][(size_t)(g * SP + p) * SC + h], bi = A.in[10][(size_t)(g * SP + p) * SC + h];
            bbr[p * 16 + h] = f_re * br - f_im * bi; bbi[p * 16 + h] = f_re * bi + f_im * br; }
    }
    for (int i = tid; i < 16 * 64; i += NWAVES * 64) { ccr[i] = A.in[11][(size_t)g * 16 * 64 + i]; cci[i] = A.in[12][(size_t)g * 16 * 64 + i]; }
    __syncthreads();
    {
        const int h = (tid >> 4) & 15, h2 = tid & 15, t0 = tid >> 8;
        float s[8];
#pragma unroll
        for (int k = 0; k < 8; ++k) s[k] = 0.f;
        for (int p = 0; p < 64; ++p) { const float cr = ccr[h * 64 + p], ci = cci[h * 64 + p], br = bbr[p * 16 + h2], bi = bbi[p * 16 + h2];
            const float U = cr * br - ci * bi, V = cr * bi + ci * br;
#pragma unroll
            for (int k = 0; k < 8; ++k) s[k] += pwr[(2 * k + t0) * 64 + p] * U - pwi[(2 * k + t0) * 64 + p] * V; }
        if (t0 == 0 && h == h2) s[0] += A.in[13][g * SC + h];
#pragma unroll
        for (int k = 0; k < 8; ++k) ktab[(2 * k + t0) * 256 + h * 16 + h2] = s[k];
    }
    __syncthreads();
    bf16* w3 = W3 + (size_t)g * 256 * X3LD;
    for (int idx = tid; idx < 256 * (X3LD / 8); idx += NWAVES * 64) {
        const int row = idx / (X3LD / 8), c8 = (idx % (X3LD / 8)) * 8, i = row >> 4, h = row & 15;
        float v[8];
        if (c8 < 256) { const int j = c8 >> 4, h0 = c8 & 15;
#pragma unroll
            for (int e = 0; e < 8; ++e) v[e] = (j <= i) ? ktab[((i - j) * 16 + h) * 16 + h0 + e] : 0.f;
        } else {
#pragma unroll
            for (int e = 0; e < 8; ++e) { const int ci = c8 - 256 + e, ri = ci >> 6, p = ci & 63; const float ar = pwr[(i + 1) * 64 + p], ai = pwi[(i + 1) * 64 + p], cr = ccr[h * 64 + p], cim = cci[h * 64 + p];
                v[e] = (ri == 0) ? (cr * ar - cim * ai) : -(cr * ai + cim * ar); }
        }
        v4u o; o.x = pk2(v[0], v[1]); o.y = pk2(v[2], v[3]); o.z = pk2(v[4], v[5]); o.w = pk2(v[6], v[7]);
        *(GAS v4u*)(w3 + (size_t)row * X3LD + c8) = o;
    }
    bf16* fm = FM + (size_t)g * 256 * 256;
    for (int idx = tid; idx < 256 * 32; idx += NWAVES * 64) {
        const int row = idx >> 5, c8 = (idx & 31) * 8;
        float v[8];
        if (row < 128) { const int ri = row >> 6, p = row & 63, j = c8 >> 4, h0 = c8 & 15; const float ar = pwr[(15 - j) * 64 + p], ai = pwi[(15 - j) * 64 + p];
#pragma unroll
            for (int e = 0; e < 8; ++e) { const float br = bbr[p * 16 + h0 + e], bi = bbi[p * 16 + h0 + e]; v[e] = (ri == 0) ? (ar * br - ai * bi) : (ar * bi + ai * br); }
        } else {
#pragma unroll
            for (int e = 0; e < 8; ++e) v[e] = 0.f;
        }
        v4u o; o.x = pk2(v[0], v[1]); o.y = pk2(v[2], v[3]); o.z = pk2(v[4], v[5]); o.w = pk2(v[6], v[7]);
        *(GAS v4u*)(fm + (size_t)row * 256 + c8) = o;
    }
    __syncthreads();
}
__device__ __forceinline__ void ssm_carry(Frame& F, const float* L, const float* AT, bf16* X3) {
    if (F.tid >= 256) return;
    for (int gid = F.vcu * 256 + F.tid; gid < SG * BATCH * SP; gid += F.G * 256) {
    const int p = gid & 63, b = (gid >> 6) & 15, g = gid >> 10;
    const float ar = AT[(g * SP + p) * 2], ai = AT[(g * SP + p) * 2 + 1];
    const size_t row0 = (size_t)g * (BATCH * NCH) + (size_t)b * NCH;
    const GAS float* lp = (const GAS float*)L + row0 * (2 * SP) + p;
    GAS bf16* xp = (GAS bf16*)X3 + row0 * X3LD + 256 + p;
    float sr = 0.f, si = 0.f;
    for (int c0 = 0; c0 < NCH; c0 += 16) {
        float lr[16], li[16];
#pragma unroll
        for (int k = 0; k < 16; ++k) { lr[k] = lp[(size_t)(c0 + k) * (2 * SP)]; li[k] = lp[(size_t)(c0 + k) * (2 * SP) + SP]; }
#pragma unroll
        for (int k = 0; k < 16; ++k) { xp[(size_t)(c0 + k) * X3LD] = (bf16)f2bf(sr); xp[(size_t)(c0 + k) * X3LD + SP] = (bf16)f2bf(si);
            const float nr = ar * sr - ai * si + lr[k], ni = ar * si + ai * sr + li[k]; sr = nr; si = ni; }
    }
    }
}

template <int GAIN, int PERMQ, bool BLK = false>
__device__ __forceinline__ void p0_transpose_item(const float* W, const float* gk, const float* gk2, int ksplit, int K, int N, bf16* WT, int ldt, LAS float* scr, int item, int lane) {
    const int nblk = N / 32, kb = item / nblk, nb = item % nblk, k0 = 64 * kb, n0 = 32 * nb;
#pragma unroll 8
    for (int i = 0; i < 32; ++i) { const int kk = 2 * i + (lane >> 5), k = k0 + kk; float w = W[(size_t)k * N + n0 + (lane & 31)];
        if constexpr (GAIN == 1) w *= gk[k];
        if constexpr (GAIN == 2) { const float* gp = (k < ksplit) ? gk + k : gk2 + (k - ksplit); w *= *gp; }
        scr[kk * 33 + (lane & 31)] = w; }
    LDS_WAIT(); asm volatile("" ::: "memory");
    int d0 = n0;
    if (PERMQ == 2 || (PERMQ == 1 && nb < 64)) { const int w8 = nb & 7; d0 = (nb & ~7) * 32 + 32 * (4 * (w8 & 1) + (w8 >> 1)); }
    const int c = lane & 7;
#pragma unroll
    for (int j = 0; j < 4; ++j) { const int n = (lane >> 3) + 8 * j; const LAS float* s = scr + (8 * c) * 33 + n;
        v4u o; o.x = pk2(s[0 * 33], s[1 * 33]); o.y = pk2(s[2 * 33], s[3 * 33]); o.z = pk2(s[4 * 33], s[5 * 33]); o.w = pk2(s[6 * 33], s[7 * 33]);
        if constexpr (BLK) { const int P = d0 + n; *(GAS v4u*)(WT + ((size_t)(P >> 8) * (K / 64) + kb) * 16384 + pg8::img_in((P & 255 & ~31) + pg8::inv_perm32(P & 31), 8 * c)) = o; }
        else *(GAS v4u*)(WT + (size_t)(d0 + n) * ldt + k0 + 8 * c) = o; }
    LDS_WAIT(); asm volatile("" ::: "memory");
}
__device__ __forceinline__ void rms_row_to_bf16(const float* xrow, bf16* orow, int rit, int lane) {
    const GAS f32x4* xr = (const GAS f32x4*)xrow + lane;
    f32x4 v[8]; float s = 0.f;
#pragma unroll
    for (int j = 0; j < 8; ++j) { v[j] = xr[64 * j]; s += (v[j].x * v[j].x + v[j].y * v[j].y) + (v[j].z * v[j].z + v[j].w * v[j].w); }
    const float r = rsqrtf(wave_sum(s) * (1.0f / (float)DM) + EPS);
    GAS bf16* ob = (GAS bf16*)orow + (size_t)(lane >> 4) * 16384 + pg8::img_in(rit, 4 * (lane & 15));
#pragma unroll
    for (int j = 0; j < 8; ++j) *(GAS unsigned long long*)(ob + (size_t)j * 4 * 16384) = (unsigned long long)pk2(v[j].x * r, v[j].y * r) | ((unsigned long long)pk2(v[j].z * r, v[j].w * r) << 32);
}
__device__ __forceinline__ void p0_prologue(Frame& F, const Args& A) {
    unsigned char* ws = A.ws;
    LAS float* scr = (LAS float*)(F.lds + RING_OFF + F.wave * 16384);
    const int gw = F.vcu * NWAVES + F.wave, NGW = F.G * NWAVES;
    for (int g = F.vcu; g < SG; g += F.G) ssm_precompute(F, A, g, (bf16*)(ws + WS_W3), (bf16*)(ws + WS_F), (float*)(ws + WS_AT));
    constexpr int I_IN = (DM / 64) * (NPROJ / 32), I_GLU = (SW / 64) * (SW / 32), I_OUT = (DM / 64) * (DM / 32), I_1 = (DM / 64) * (DFF / 32), I_2 = (DFF / 64) * (DM / 32);
    constexpr int NITEMS = I_IN + I_GLU + I_OUT + I_1 + I_2;
    for (int it = gw; it < NITEMS; it += NGW) {
        int r = it;
        if (r < I_IN) { p0_transpose_item<1, 1, true>(A.in[2], A.in[1], A.in[1], DM, DM, NPROJ, (bf16*)(ws + WS_WIN), 64, scr, r, F.lane); continue; } r -= I_IN;
        if (r < I_GLU) { p0_transpose_item<0, 0, 1>(A.in[14], A.in[14], A.in[14], SW, SW, SW, (bf16*)(ws + WS_WGLU), 64, scr, r, F.lane); continue; } r -= I_GLU;
        if (r < I_OUT) { p0_transpose_item<2, 0, true>(A.in[17], A.in[5], A.in[16], AW, DM, DM, (bf16*)(ws + WS_WOUT), 64, scr, r, F.lane); continue; } r -= I_OUT;
        if (r < I_1) { p0_transpose_item<1, 2, true>(A.in[19], A.in[18], A.in[18], DM, DM, DFF, (bf16*)(ws + WS_W1), 64, scr, r, F.lane); continue; } r -= I_1;
        p0_transpose_item<0, 0, true>(A.in[20], A.in[20], A.in[20], DFF, DFF, DM, (bf16*)(ws + WS_W2), 64, scr, r, F.lane);
    }
    __syncthreads();
    {   int it2 = 0; const int lane = F.lane;
        f32x4 v[2][8];
#define P0_LOADX(g_) do { _Pragma("unroll") for (int rr2 = 0; rr2 < 2; ++rr2) { const GAS f32x4* xr = (const GAS f32x4*)(A.in[0] + (size_t)((g_) * 16 + 2 * F.wave + rr2) * DM) + lane; \
            _Pragma("unroll") for (int j = 0; j < 8; ++j) v[rr2][j] = xr[64 * j]; } } while (0)
        if (F.vcu < MTOK / 16) P0_LOADX(F.vcu);
        for (int grp = F.vcu; grp < MTOK / 16; ++it2) {
            LAS unsigned char* buf = F.lds + RING_OFF + (it2 & 1) * 65536;
            if (F.tid == 0) F.MISC[16 + (it2 & 1)] = (unsigned)F.G + __hip_atomic_fetch_add(F.ctl + CW_XQ, 1u, RLX_AGENT);
#pragma unroll
            for (int rr2 = 0; rr2 < 2; ++rr2) {
                const int r = 2 * F.wave + rr2;
                float sq = 0.f;
#pragma unroll
                for (int j = 0; j < 8; ++j) sq += (v[rr2][j].x * v[rr2][j].x + v[rr2][j].y * v[rr2][j].y) + (v[rr2][j].z * v[rr2][j].z + v[rr2][j].w * v[rr2][j].w);
                const float rn = rsqrtf(wave_sum(sq) * (1.0f / (float)DM) + EPS);
                const int c = 4 * (lane & 15), inoff = (c >> 5) * 1024 + ((r * 64 + (c & 31) * 2) ^ (((r >> 3) & 1) << 5));
#pragma unroll
                for (int j = 0; j < 8; ++j) *(LAS unsigned long long*)(buf + (4 * j + (lane >> 4)) * 2048 + inoff) = (unsigned long long)pk2(v[rr2][j].x * rn, v[rr2][j].y * rn) | ((unsigned long long)pk2(v[rr2][j].z * rn, v[rr2][j].w * rn) << 32);
            }
            LDS_WAIT(); __syncthreads();
            const int nxt = (int)F.MISC[16 + (it2 & 1)];
            if (nxt < MTOK / 16) P0_LOADX(nxt);
            {   const int q = grp & 15;
                GAS unsigned char* dst = (GAS unsigned char*)(ws + WS_XB) + (size_t)(grp >> 4) * (DM / 64) * 32768 + (q >> 3) * 16384 + (q & 7) * 2048;
#pragma unroll
                for (int k = 0; k < 8; ++k) { const int sub = F.wave + 8 * k, kt = sub >> 1, cs = sub & 1;
                    const v4u w = *(const LAS v4u*)(buf + sub * 1024 + lane * 16);
                    *(GAS v4u*)(dst + (size_t)kt * 32768 + cs * 1024 + lane * 16) = w; }
            }
            grp = nxt;
        }
#undef P0_LOADX
        __syncthreads();
    }
}

__global__ void __launch_bounds__(NWAVES * 64, 2) hymba_fwd(Args args) {
    extern __shared__ __attribute__((aligned(16))) unsigned char lds[];
    Frame F;
    F.lds = (LAS unsigned char*)lds;
    F.MISC = (volatile LAS unsigned*)(F.lds + MISC_OFF);
    F.tid = threadIdx.x; F.lane = F.tid & 63; F.wave = __builtin_amdgcn_readfirstlane(F.tid >> 6);
    F.G = gridDim.x; { const int bx = blockIdx.x; F.vcu = (F.G % 8 == 0) ? (bx % 8) * (F.G / 8) + bx / 8 : bx; }
    unsigned char* ws = args.ws;
    F.ctl = (gu32*)(ws + WS_CTL);
    for (int u = F.tid; u < (LDS_BYTES - LDSCTL_OFF) / 4; u += NWAVES * 64) ((LAS unsigned*)(F.lds + LDSCTL_OFF))[u] = 0u;
    __syncthreads();
    XcdBarrier bar = xcd_barrier_post((unsigned*)(F.ctl + CW_BAR), F.MISC + 8);
#define GRID_BAR(k) xcd_barrier(bar)
#define GROUP_BAR(n) do { if ((F.G & 7) == 0) group_barrier((unsigned*)(F.ctl + CW_GB) + 64 * ((int)blockIdx.x & 7), (unsigned)(n) * (unsigned)(F.G >> 3), (unsigned*)(F.ctl + CW_BAR)); else xcd_barrier(bar); } while (0)

    bf16* const XB = (bf16*)(ws + WS_XB); bf16* const QB = (bf16*)(ws + WS_Q); bf16* const KB = (bf16*)(ws + WS_K); bf16* const VB = (bf16*)(ws + WS_V);
    bf16* const X3 = (bf16*)(ws + WS_X3); bf16* const ACT = (bf16*)(ws + WS_ACT);
    bf16* const X1B = (bf16*)(ws + WS_X1B); bf16* const HID = (bf16*)(ws + WS_HID);
    float* const KMEAN = (float*)(ws + WS_KMEAN); float* const ROWSQ = (float*)(ws + WS_ROWSQ); float* const ROWSQA = ROWSQ + MTOK; float* const ROWSQS = ROWSQ + 2 * MTOK;

    p0_prologue(F, args);
    GRID_BAR(0);
    {   pg8::Gemm g{XB, (const bf16*)(ws + WS_WIN), MTOK, NPROJ, DM, 64, 64, true, true}; pg8::StaticOrder S; S.init(MTOK, NPROJ, F.G, (int)blockIdx.x);
        pg8::EpiProj E{QB, KB, VB, X3, KMEAN, args.in[3], args.in[4]};
        pg8::gemm_phase<pg8::EpiProj, pg8::StaticOrder, true, true>(F.lds + RING_OFF, g, S, E); }
    GRID_BAR(1);
    for (int pass = 0; pass * (int)F.G < SG * 8; ++pass) {
        pg8::Gemm g{X3, (const bf16*)(ws + WS_F), SG * BATCH * NCH, 256, SCH * SC, X3LD, SCH * SC}; pg8::GroupOrder1 S{(int)F.G, F.vcu, pass};
        pg8::EpiSsmLC E{(const float*)(ws + WS_AT), X3};
        pg8::gemm_phase<pg8::EpiSsmLC, pg8::GroupOrder1, true, true>(F.lds + RING_OFF, g, S, E); }
    {   const attn_body::AttnTensors AT{(const attn_body::bf16*)QB, (const attn_body::bf16*)KB, (const attn_body::bf16*)VB, (attn_body::bf16*)XB, KMEAN, ROWSQA};
        const attn_body::StaticOrder S((int)F.G, F.vcu);
        attn_body::attn_phase<attn_body::StaticOrder>((char*)lds + RING_OFF, AT, S); }
    GRID_BAR(3);
    {   pg8::Gemm g{X3, (const bf16*)(ws + WS_W3), SG * BATCH * NCH, 256, X3LD, X3LD, X3LD}; pg8::GroupOrder S{(int)F.G, F.vcu};
        pg8::EpiSsmY E{ACT};
        pg8::gemm_phase<pg8::EpiSsmY, pg8::GroupOrder, true, true>(F.lds + RING_OFF, g, S, E); }
    GRID_BAR(4);
    {   pg8::Gemm g{ACT, (const bf16*)(ws + WS_WGLU), MTOK, SW, SW, 64, 64, true, true}; pg8::StaticOrder S; S.init(MTOK, SW, F.G, (int)blockIdx.x);
        pg8::EpiGlu E{ACT, XB, args.in[15], ROWSQS};
        pg8::gemm_phase<pg8::EpiGlu, pg8::StaticOrder, true, true>(F.lds + RING_OFF, g, S, E); }
    GROUP_BAR(1);
    {   pg8::Gemm g{XB, (const bf16*)(ws + WS_WOUT), MTOK, DM, DM, 64, 64, true, true}; pg8::StaticOrder S; S.init(MTOK, DM, F.G, (int)blockIdx.x);
        pg8::EpiWout E{args.in[0], X1B, ROWSQ, ROWSQA, ROWSQS};
        pg8::gemm_phase<pg8::EpiWout, pg8::StaticOrder, true, true>(F.lds + RING_OFF, g, S, E); }
    GROUP_BAR(2);
    {   pg8::Gemm g{X1B, (const bf16*)(ws + WS_W1), MTOK, DFF, DM, 64, 64, true, true}; pg8::StaticOrder S; S.init(MTOK, DFF, F.G, (int)blockIdx.x);
        pg8::EpiFF1 E{HID, ROWSQ};
        pg8::gemm_phase<pg8::EpiFF1, pg8::StaticOrder, true, true>(F.lds + RING_OFF, g, S, E); }
    GROUP_BAR(3);
    {   pg8::Gemm g{HID, (const bf16*)(ws + WS_W2), MTOK, DM, DFF, 64, 64, true, true}; pg8::StaticOrder S; S.init(MTOK, DM, F.G, (int)blockIdx.x, 4);
        pg8::EpiFF2 E{args.out, X1B};
        pg8::gemm_phase<pg8::EpiFF2, pg8::StaticOrder, true, true>(F.lds + RING_OFF, g, S, E); }
#undef GRID_BAR
#undef GROUP_BAR
}

extern "C" void kernel_launch(void* const* d_in, const int* in_sizes, int n_in, void* d_out, int out_size, void* d_ws, size_t ws_size, hipStream_t stream) {
    static int grid = 0;
    if (grid == 0) {
        if (n_in != 21 || in_sizes[0] != MTOK * DM || out_size != MTOK * DM || ws_size < WS_END) { fprintf(stderr, "kernel_launch: unexpected shapes (n_in %d, in0 %d, out %d, ws %zu); nothing launched\n", n_in, n_in > 0 ? in_sizes[0] : -1, out_size, ws_size); grid = -1; return; }
        int dev = 0, cus = 0, per_cu = 0;
        if (hipGetDevice(&dev) != hipSuccess || hipDeviceGetAttribute(&cus, hipDeviceAttributeMultiprocessorCount, dev) != hipSuccess) { grid = -1; return; }
        if (hipFuncSetAttribute((const void*)hymba_fwd, hipFuncAttributeMaxDynamicSharedMemorySize, LDS_BYTES) != hipSuccess) { fprintf(stderr, "kernel_launch: hipFuncSetAttribute failed\n"); grid = -1; return; }
        if (hipOccupancyMaxActiveBlocksPerMultiprocessor(&per_cu, (const void*)hymba_fwd, NWAVES * 64, LDS_BYTES) != hipSuccess || per_cu < 1) { fprintf(stderr, "kernel_launch: occupancy query reports %d workgroups per CU\n", per_cu); (void)hipGetLastError(); grid = -1; return; }
        grid = cus;
    }
    if (grid < 0) return;
    if (hipMemsetAsync((char*)d_ws + WS_CTL, 0, CTL_ZERO_BYTES, stream) != hipSuccess) return;
    Args a{};
    for (int i = 0; i < 21; ++i) a.in[i] = (const float*)d_in[i];
    a.out = (float*)d_out; a.ws = (unsigned char*)d_ws;
    hipLaunchKernelGGL(hymba_fwd, dim3(grid), dim3(NWAVES * 64), LDS_BYTES, stream, a);
}
```
